# Optimizing an MI355X kernel written in HIP

```python
import jax
import jax.numpy as jnp
from jax import lax
import numpy as np

D_MODEL = 1024
BATCH = 4
SEQ = 4096
DEPTH = 2

GRID_W = 64
CTX_LEN = 256
EPS = 1e-6
N_MOD = 9
D_FF = 2816

CONV_A_W = 256
CONV_A_K = 3
SGU_W = 256
SGU_GROUPS = 4
SGU_GROUP_W = SGU_W // SGU_GROUPS
CHUNK = 128
DA_HEADS = 4
DA_HEAD_DIM = 64
DA_W = DA_HEADS * 2 * DA_HEAD_DIM
ROPE_BASE = 10000.0
ROPE_NF = DA_HEAD_DIM // 4
Q_BLOCK = 128
CONF_W = 256
CONF_K = 31
N_BRANCH = 4

A_OFF = 0
B_OFF = A_OFF + 3 * CONV_A_W
Q_OFF = B_OFF + 2 * SGU_W
K_OFF = Q_OFF + DA_W
V_OFF = K_OFF + DA_W
D_OFF = V_OFF + DA_W
G_OFF = D_OFF + 2 * CONF_W
IN_COLS = G_OFF + N_BRANCH * D_MODEL

kernel_name = "hybrid_gated_mixers_dit_block"


def rmsnorm(x, g):
    xf = x.astype(jnp.float32)
    y = xf * lax.rsqrt(jnp.mean(xf * xf, axis=-1, keepdims=True) + EPS)
    return (y * g.astype(jnp.float32)).astype(x.dtype)


def layernorm_plain(x):
    xf = x.astype(jnp.float32)
    mu = jnp.mean(xf, axis=-1, keepdims=True)
    var = jnp.mean(jnp.square(xf - mu), axis=-1, keepdims=True)
    return ((xf - mu) * lax.rsqrt(var + EPS)).astype(x.dtype)


def layernorm_affine(x, g, b):
    return (layernorm_plain(x) * g + b).astype(x.dtype)


def modulated_norm(x, g, shift, scale):
    return rmsnorm(x, g) * (1 + scale) + shift


def swiglu(h, w1, w3, w2):
    return (jax.nn.silu(h @ w1) * (h @ w3)) @ w2


def dwconv_centred(x, w):
    k = w.shape[0]
    return lax.conv_general_dilated(
        x, w[:, None, :].astype(x.dtype), window_strides=(1,),
        padding=[(k // 2, k // 2)], dimension_numbers=("NWC", "WIO", "NWC"),
        feature_group_count=x.shape[-1])


def axial_rope_tables(n_tokens):
    n_rows = n_tokens // GRID_W
    row = jnp.repeat(jnp.arange(n_rows, dtype=jnp.float32), GRID_W)
    col = jnp.tile(jnp.arange(GRID_W, dtype=jnp.float32), n_rows)
    inv = ROPE_BASE ** (-jnp.arange(ROPE_NF, dtype=jnp.float32) / ROPE_NF)
    ang = jnp.stack([row[:, None] * inv, col[:, None] * inv], axis=1)
    ang = ang[:, None, None]
    return jnp.cos(ang), jnp.sin(ang)


def apply_rope(x, cos, sin):
    xs = x.reshape(x.shape[:-1] + (2, 2, ROPE_NF))
    x1, x2 = xs[..., 0, :], xs[..., 1, :]
    cos, sin = cos.astype(x.dtype), sin.astype(x.dtype)
    out = jnp.stack([x1 * cos - x2 * sin, x2 * cos + x1 * sin], axis=-2)
    return out.reshape(x.shape)


def heads_qk(p):
    return p.reshape(p.shape[:2] + (DA_HEADS, 2, DA_HEAD_DIM))


def heads_v(p):
    return p.reshape(p.shape[:2] + (DA_HEADS, 2 * DA_HEAD_DIM))


def diff_attend(q, k, v, lam):
    s = jnp.einsum("bqhmd,bkhmd->bmhqk", q, k).astype(jnp.float32) * (DA_HEAD_DIM ** -0.5)
    p = jax.nn.softmax(s, axis=-1)
    a = p[:, 0] - lam * p[:, 1]
    return jnp.einsum("bhqk,bkhe->bqhe", a.astype(v.dtype), v)


def diff_attn_out(o, subln_g, lam_init, w_c_out):
    o = rmsnorm(o, subln_g) * (1 - lam_init)
    return o.reshape(o.shape[:2] + (DA_W,)) @ w_c_out


def short_conv_branch(p, conv_w, w_out):
    bg, cg, xin = jnp.split(p[..., A_OFF:B_OFF], 3, axis=-1)
    return (bg * dwconv_centred(cg * xin, conv_w)) @ w_out


def sgu_branch(p, w_s, b_s, w_out):
    z = jax.nn.gelu(p[..., B_OFF:Q_OFF])
    u, v = jnp.split(z, 2, axis=-1)
    v = layernorm_plain(v)
    bsz, t = v.shape[:2]
    vc = v.reshape(bsz, t // CHUNK, CHUNK, SGU_GROUPS, SGU_GROUP_W)
    s = jnp.einsum("gpq,bnqgc->bnpgc", w_s, vc) + b_s.T[:, :, None]
    return (u * s.reshape(bsz, t, SGU_W)) @ w_out


def conformer_conv_branch(p, dw, db, ln_g, ln_b, w_out):
    z = p[..., D_OFF:G_OFF]
    h = z[..., :CONF_W] * jax.nn.sigmoid(z[..., CONF_W:])
    h = dwconv_centred(h, dw) + db
    h = jax.nn.silu(layernorm_affine(h, ln_g, ln_b))
    return h @ w_out


def mix_stream(p, yc, conv_a_w, w_a_out, sgu_w, sgu_b, w_b_out,
               conf_dw, conf_db, conf_ln_g, conf_ln_b, w_d_out, w_o):
    ya = short_conv_branch(p, conv_a_w, w_a_out)
    yb = sgu_branch(p, sgu_w, sgu_b, w_b_out)
    yd = conformer_conv_branch(p, conf_dw, conf_db, conf_ln_g, conf_ln_b, w_d_out)
    g = jax.nn.sigmoid(p[..., G_OFF:]).reshape(p.shape[:2] + (N_BRANCH, D_MODEL))
    merged = g[:, :, 0] * ya + g[:, :, 1] * yb + g[:, :, 2] * yc + g[:, :, 3] * yd
    return merged @ w_o


def setup_inputs(seed: int = 0) -> dict:
    key = jax.random.key(seed)
    ks = iter(jax.random.split(key, 32))

    def nrm(shape, scale):
        return scale * jax.random.normal(next(ks), shape, jnp.float32)

    L, D = DEPTH, D_MODEL
    return {
        "x": nrm((BATCH, SEQ, D), 1.0),
        "c": nrm((BATCH, D), 1.0),
        "ctx": nrm((BATCH, CTX_LEN, D), 1.0),
        "c_ctx": nrm((D,), 1.0),
        "w_ada": nrm((L, D, N_MOD * D), 0.5 * D ** -0.5),
        "b_ada": nrm((L, N_MOD * D), 0.02),
        "norm_g": 1.0 + nrm((L, 3, D), 0.02),
        "ffn1_w1": nrm((L, D, D_FF), D ** -0.5),
        "ffn1_w3": nrm((L, D, D_FF), D ** -0.5),
        "ffn1_w2": nrm((L, D_FF, D), D_FF ** -0.5),
        "ffn2_w1": nrm((L, D, D_FF), D ** -0.5),
        "ffn2_w3": nrm((L, D, D_FF), D ** -0.5),
        "ffn2_w2": nrm((L, D_FF, D), D_FF ** -0.5),
        "w_in": nrm((L, D, IN_COLS), D ** -0.5),
        "conv_a_w": nrm((L, CONV_A_K, CONV_A_W), CONV_A_K ** -0.5),
        "w_a_out": nrm((L, CONV_A_W, D), CONV_A_W ** -0.5),
        "sgu_w": nrm((L, SGU_GROUPS, CHUNK, CHUNK), CHUNK ** -0.5),
        "sgu_b": nrm((L, SGU_GROUPS, CHUNK), 0.02),
        "w_b_out": nrm((L, SGU_W, D), SGU_W ** -0.5),
        "lam_p": nrm((L, 4, DA_HEAD_DIM), 0.1),
        "subln_g": 1.0 + nrm((L, 2 * DA_HEAD_DIM), 0.02),
        "w_c_out": nrm((L, DA_W, D), DA_W ** -0.5),
        "conf_dw": nrm((L, CONF_K, CONF_W), CONF_K ** -0.5),
        "conf_db": nrm((L, CONF_W), 0.02),
        "conf_ln_g": 1.0 + nrm((L, CONF_W), 0.02),
        "conf_ln_b": nrm((L, CONF_W), 0.02),
        "w_d_out": nrm((L, CONF_W, D), CONF_W ** -0.5),
        "w_o": nrm((L, D, D), D ** -0.5),
        "final_g": 1.0 + nrm((D,), 0.02),
    }


def reference(x, c, ctx, c_ctx, w_ada, b_ada, norm_g, ffn1_w1, ffn1_w3, ffn1_w2,
              ffn2_w1, ffn2_w3, ffn2_w2, w_in, conv_a_w, w_a_out, sgu_w, sgu_b,
              w_b_out, lam_p, subln_g, w_c_out, conf_dw, conf_db, conf_ln_g,
              conf_ln_b, w_d_out, w_o, final_g):
    bsz, n_tok = x.shape[:2]
    n_blk = n_tok // Q_BLOCK
    cos, sin = axial_rope_tables(n_tok)
    sc = jax.nn.silu(c)[:, None, :]
    scc = jax.nn.silu(c_ctx)[None, None, :]
    for l in range(DEPTH):
        last = l == DEPTH - 1
        mx = jnp.split(sc @ w_ada[l] + b_ada[l], N_MOD, axis=-1)
        mc = jnp.split(scc @ w_ada[l] + b_ada[l], N_MOD, axis=-1)
        lam_init = 0.8 - 0.6 * float(np.exp(-0.3 * l))
        lp = lam_p[l].astype(jnp.float32)
        lam = jnp.exp(jnp.sum(lp[0] * lp[1])) - jnp.exp(jnp.sum(lp[2] * lp[3])) + lam_init
        ffn1 = (ffn1_w1[l], ffn1_w3[l], ffn1_w2[l])
        ffn2 = (ffn2_w1[l], ffn2_w3[l], ffn2_w2[l])
        lw = (conv_a_w[l], w_a_out[l], sgu_w[l], sgu_b[l], w_b_out[l],
              conf_dw[l], conf_db[l], conf_ln_g[l], conf_ln_b[l], w_d_out[l], w_o[l])

        x = x + 0.5 * mx[2] * swiglu(modulated_norm(x, norm_g[l, 0], mx[0], mx[1]), *ffn1)
        ctx = ctx + 0.5 * mc[2] * swiglu(modulated_norm(ctx, norm_g[l, 0], mc[0], mc[1]), *ffn1)

        hx = modulated_norm(x, norm_g[l, 1], mx[3], mx[4])
        hc = modulated_norm(ctx, norm_g[l, 1], mc[3], mc[4])
        px = hx @ w_in[l]
        if last:
            pc_kv = hc @ w_in[l][:, K_OFF:D_OFF]
            kc, vc = heads_qk(pc_kv[..., :DA_W]), heads_v(pc_kv[..., DA_W:])
        else:
            pc = hc @ w_in[l]
            qc = heads_qk(pc[..., Q_OFF:K_OFF])
            kc = heads_qk(pc[..., K_OFF:V_OFF])
            vc = heads_v(pc[..., V_OFF:D_OFF])
        qx = apply_rope(heads_qk(px[..., Q_OFF:K_OFF]), cos, sin)
        kx = apply_rope(heads_qk(px[..., K_OFF:V_OFF]), cos, sin)
        vx = heads_v(px[..., V_OFF:D_OFF])
        k_all = jnp.concatenate([kx, kc], axis=1)
        v_all = jnp.concatenate([vx, vc], axis=1)
        qb = jnp.moveaxis(qx.reshape((bsz, n_blk, Q_BLOCK) + qx.shape[2:]), 1, 0)
        ob = lax.map(lambda qi: diff_attend(qi, k_all, v_all, lam), qb)
        ox = jnp.moveaxis(ob, 0, 1).reshape((bsz, n_tok) + ob.shape[3:])
        yc_x = diff_attn_out(ox, subln_g[l], lam_init, w_c_out[l])
        x = x + mx[5] * mix_stream(px, yc_x, *lw)

        x = x + 0.5 * mx[8] * swiglu(modulated_norm(x, norm_g[l, 2], mx[6], mx[7]), *ffn2)

        if not last:
            oc = diff_attend(qc, kc, vc, lam)
            yc_c = diff_attn_out(oc, subln_g[l], lam_init, w_c_out[l])
            ctx = ctx + mc[5] * mix_stream(pc, yc_c, *lw)
            ctx = ctx + 0.5 * mc[8] * swiglu(modulated_norm(ctx, norm_g[l, 2], mc[6], mc[7]), *ffn2)

    return rmsnorm(x, final_g)
```

```cpp
#include <hip/hip_runtime.h>
#include <hip/hip_cooperative_groups.h>
#include <hip/hip_bf16.h>
#include <cstdio>
#include <cstdint>
#include <cmath>
namespace cg = cooperative_groups;
__device__ __forceinline__ int tid_now() { int t = threadIdx.x; asm volatile("" : "+v"(t)); return t; }
#ifndef MK_PER_PHASE
#define MK_PER_PHASE 0
#endif
#ifndef MK_NPH
#define MK_NPH 24
#endif
#ifndef MK_BRMASK
#define MK_BRMASK 15
#endif
#ifndef MK_REP_PH
#define MK_REP_PH -1
#endif
#ifndef MK_REP_ATTN
#define MK_REP_ATTN 1
#endif
namespace pg8 {
#define PG8_LAS __attribute__((address_space(3)))
typedef unsigned short bf16_t;
typedef short bf16x8 __attribute__((ext_vector_type(8)));
typedef float f32x4 __attribute__((ext_vector_type(4)));
typedef unsigned u32x4 __attribute__((ext_vector_type(4)));
typedef PG8_LAS unsigned char* LdsPtr;
constexpr int BM = 256, BK = 64, HALF = 128, HTB = HALF * BK * 2  , STAGE_BYTES = 8 * HTB, NXCD = 8, WGM = 8;

__host__ __device__ __forceinline__ int lds_byte(int r, int c) { const int st = (r >> 4) * 2 + (c >> 5), rr = r & 15, cc = c & 31, ob = rr * 64 + cc * 2; return st * 1024 + (ob ^ (((ob >> 9) & 1) << 5)); }
__host__ __device__ __forceinline__ void stage_rc(int b, int& R, int& C) { const int st = b / 1024, sb = b % 1024, swz = sb ^ (((sb >> 9) & 1) << 5); R = (st >> 1) * 16 + swz / 64; C = (st & 1) * 32 + (swz % 64) / 2; }
__host__ __device__ __forceinline__ int perm32(int rho) { const int n = rho >> 4, i = rho & 15; return 8 * (i >> 2) + 4 * n + (i & 3); }

struct Unit { int pm, pn; };
struct Gemm { const bf16_t* A; const bf16_t* Bt; int lda, ldb, K; };

struct StaticOrder {
    int nM, nN, nwg, G, c;
    __host__ __device__ void init(int M, int N, int G_, int c_) { nM = M / BM; nN = N / BM; nwg = nM * nN; G = G_; c = c_; }
    __host__ __device__ bool next(int i, Unit& u) const {
        const long L = (long)i * G + c; if (L >= nwg) return false;
        int wgid = (int)L; { const int q = nwg / NXCD, r = nwg % NXCD, xcd = wgid % NXCD, off = wgid / NXCD; wgid = (xcd < r ? xcd * (q + 1) : r * (q + 1) + (xcd - r) * q) + off; }
        const int nig = WGM * nN, gid = wgid / nig, fm = gid * WGM, gsz = (nM - fm) < WGM ? (nM - fm) : WGM;
        u.pm = fm + ((wgid % nig) % gsz); u.pn = (wgid % nig) / gsz; return true;
    }
    __device__ __forceinline__ void a_ready(const Unit&) const {}
    __device__ __forceinline__ void done(const Unit&) const {}
};


struct OneUnit {
    Unit u;
    __device__ __forceinline__ bool next(int i, Unit& o) const { if (i) return false; o = u; return true; }
    __device__ __forceinline__ void a_ready(const Unit&) const {}
    __device__ __forceinline__ void done(const Unit&) const {}
};

typedef float f32x2_cv __attribute__((ext_vector_type(2))); typedef __bf16 bf16x2_cv __attribute__((ext_vector_type(2)));
__device__ __forceinline__ unsigned cvt_pk_bf16(float lo, float hi) { f32x2_cv v = {lo, hi}; bf16x2_cv b = __builtin_convertvector(v, bf16x2_cv); return __builtin_bit_cast(unsigned, b); }
typedef unsigned u32x2 __attribute__((ext_vector_type(2)));
__device__ __forceinline__ float fsigmoid(float v) { return __builtin_amdgcn_rcpf(1.0f + __builtin_amdgcn_exp2f(-1.4426950408889634f * v)); }
__device__ __forceinline__ float fsilu(float v) { return v * fsigmoid(v); }
__device__ __forceinline__ float ftanh(float v) { return 2.0f * fsigmoid(2.0f * v) - 1.0f; }
__device__ __forceinline__ float fgelu_tanh(float v) { const float u = 0.7978845608028654f * (v + 0.044715f * v * v * v); return v * fsigmoid(2.0f * u); }
__device__ __forceinline__ float bf_lo(unsigned w) { return __uint_as_float(w << 16); }
__device__ __forceinline__ float bf_hi(unsigned w) { return __uint_as_float(w & 0xffff0000u); }

constexpr int ROWS_X = 16384, PXW = 3328, DFF = 2816, MODW = 9216;

struct EpiSwiGLU {
    static constexpr bool PERM = true, AFTER_DRAIN = false;
    bf16_t* H;
    __device__ __forceinline__ void operator()(const f32x4 (&acc)[2][2][4][2], const Unit& u, int wr, int wc, int fr, int fq) const {
        const int row0 = u.pm * BM + wr * 64 + fr, col0 = u.pn * HALF + wc * 32 + 8 * fq;
#pragma unroll
        for (int ai = 0; ai < 2; ++ai)
#pragma unroll
            for (int m = 0; m < 4; ++m) {
                bf16_t* rowp = H + (size_t)(row0 + ai * HALF + m * 16) * DFF + col0;
                const f32x4 a0 = acc[ai][0][m][0], a1 = acc[ai][0][m][1], b0 = acc[ai][1][m][0], b1 = acc[ai][1][m][1];
                u32x4 w;
                w.x = cvt_pk_bf16(fsilu(a0[0]) * b0[0], fsilu(a0[1]) * b0[1]); w.y = cvt_pk_bf16(fsilu(a0[2]) * b0[2], fsilu(a0[3]) * b0[3]);
                w.z = cvt_pk_bf16(fsilu(a1[0]) * b1[0], fsilu(a1[1]) * b1[1]); w.w = cvt_pk_bf16(fsilu(a1[2]) * b1[2], fsilu(a1[3]) * b1[3]);
                *(u32x4*)rowp = w;
            }
    }
};

struct EpiRes {
    static constexpr bool PERM = false, AFTER_DRAIN = false;
    const float* bx; const float* bc; float* ox; float* oc; const float* gate; float sc;
    __device__ __forceinline__ void operator()(const f32x4 (&acc)[2][2][4][2], const Unit& u, int wr, int wc, int fr, int fq) const {
        const bool isx = u.pm < 64; const int set = isx ? (u.pm >> 4) : 4;
        const size_t roff = (size_t)(isx ? u.pm : u.pm - 64) * BM * 1024;
        const float* base = (isx ? bx : bc) + roff; float* out = (isx ? ox : oc) + roff;
        const int col0 = u.pn * BM + wc * 32 + 4 * fq; const float* gp = gate + (size_t)set * MODW + col0;
        f32x4 gv[2][2];
#pragma unroll
        for (int bj = 0; bj < 2; ++bj)
#pragma unroll
            for (int n = 0; n < 2; ++n) gv[bj][n] = *(const f32x4*)(gp + bj * HALF + n * 16) * sc;
#pragma unroll
        for (int ai = 0; ai < 2; ++ai)
#pragma unroll
            for (int m = 0; m < 4; ++m) {
                const size_t off = (size_t)(ai * HALF + wr * 64 + m * 16 + fr) * 1024 + col0;
#pragma unroll
                for (int bj = 0; bj < 2; ++bj)
#pragma unroll
                    for (int n = 0; n < 2; ++n) {
                        const f32x4 b = *(const f32x4*)(base + off + bj * HALF + n * 16);
                        *(f32x4*)(out + off + bj * HALF + n * 16) = b + gv[bj][n] * acc[ai][bj][m][n];
                    }
            }
    }
};

__device__ __forceinline__ float lane32_partner(float x, bool hi) { auto rr = __builtin_amdgcn_permlane32_swap(__float_as_uint(x), __float_as_uint(x), false, false); return __uint_as_float(hi ? rr[0] : rr[1]); }
struct EpiWin {
    static constexpr bool PERM = true, AFTER_DRAIN = false;
    bf16_t* PX; const float* rcos; const float* rsin; float qscale;
    __device__ __forceinline__ void operator()(const f32x4 (&acc)[2][2][4][2], const Unit& u, int wr, int wc, int fr, int fq) const {
        const int pn = u.pn; const bool isx = u.pm < 64;
        const bool gel = (pn == 3 || pn == 4), isq = (pn == 5 || pn == 6), rope = (pn >= 5 && pn <= 8) && isx;
        const float sc = isq ? qscale : 1.0f; const bool hi = fq >= 2; const float sgn = hi ? 1.0f : -1.0f;
        const int col0 = pn * BM + wc * 32 + 8 * fq;
#pragma unroll
        for (int ai = 0; ai < 2; ++ai)
#pragma unroll
            for (int m = 0; m < 4; ++m) {
                const int row = u.pm * BM + ai * HALF + wr * 64 + m * 16 + fr;
                bf16_t* rowp = PX + (size_t)row * PXW + col0;
                f32x4 c0 = (f32x4){1.f, 1.f, 1.f, 1.f}, c1 = c0, s0 = (f32x4){0.f, 0.f, 0.f, 0.f}, s1 = s0;
                if (rope) { const int pos = (wc & 1) ? (m * 16 + fr) : ((4 * u.pm + 2 * ai + wr) & 63); const int fo = pos * 16 + 8 * (fq & 1);
                    c0 = *(const f32x4*)(rcos + fo); c1 = *(const f32x4*)(rcos + fo + 4); s0 = *(const f32x4*)(rsin + fo) * sgn; s1 = *(const f32x4*)(rsin + fo + 4) * sgn; }
#pragma unroll
                for (int bj = 0; bj < 2; ++bj) {
                    f32x4 v0 = acc[ai][bj][m][0], v1 = acc[ai][bj][m][1];
                    if (gel) {
#pragma unroll
                        for (int i = 0; i < 4; ++i) { v0[i] = fgelu_tanh(v0[i]); v1[i] = fgelu_tanh(v1[i]); }
                    }
                    if (rope) { f32x4 p0, p1;
#pragma unroll
                        for (int i = 0; i < 4; ++i) { p0[i] = lane32_partner(v0[i], hi); p1[i] = lane32_partner(v1[i], hi); }
                        v0 = v0 * c0 + p0 * s0; v1 = v1 * c1 + p1 * s1; }
                    v0 = v0 * sc; v1 = v1 * sc;
                    u32x4 w; w.x = cvt_pk_bf16(v0[0], v0[1]); w.y = cvt_pk_bf16(v0[2], v0[3]); w.z = cvt_pk_bf16(v1[0], v1[1]); w.w = cvt_pk_bf16(v1[2], v1[3]);
                    *(u32x4*)(rowp + bj * HALF) = w;
                }
            }
    }
};

struct EpiGate {
    static constexpr bool PERM = true, AFTER_DRAIN = false;
    bf16_t* GS;
    __device__ __forceinline__ void operator()(const f32x4 (&acc)[2][2][4][2], const Unit& u, int wr, int wc, int fr, int fq) const {
        const int tid = tid_now();
#pragma unroll
        for (int ai = 0; ai < 2; ++ai)
#pragma unroll
            for (int bj = 0; bj < 2; ++bj)
#pragma unroll
                for (int m = 0; m < 4; ++m) {
                    const f32x4 a0 = acc[ai][bj][m][0], a1 = acc[ai][bj][m][1];
                    u32x4 w; w.x = cvt_pk_bf16(fsigmoid(a0[0]), fsigmoid(a0[1])); w.y = cvt_pk_bf16(fsigmoid(a0[2]), fsigmoid(a0[3]));
                    w.z = cvt_pk_bf16(fsigmoid(a1[0]), fsigmoid(a1[1])); w.w = cvt_pk_bf16(fsigmoid(a1[2]), fsigmoid(a1[3]));
                    *(u32x4*)(GS + ((size_t)(((ai * 2 + bj) * 4 + m) * 512 + tid)) * 8) = w;
                }
    }
};

struct EpiBranch {
    static constexpr bool PERM = true, AFTER_DRAIN = false;
    const bf16_t* GS; bf16_t* MG; int first;
    __device__ __forceinline__ void operator()(const f32x4 (&acc)[2][2][4][2], const Unit& u, int wr, int wc, int fr, int fq) const {
        const int tid = tid_now();
        const int row0 = u.pm * BM + wr * 64 + fr, col0 = u.pn * BM + wc * 32 + 8 * fq;
#pragma unroll
        for (int ai = 0; ai < 2; ++ai)
#pragma unroll
            for (int bj = 0; bj < 2; ++bj)
#pragma unroll
                for (int m = 0; m < 4; ++m) {
                    const u32x4 g = *(const u32x4*)(GS + ((size_t)(((ai * 2 + bj) * 4 + m) * 512 + tid)) * 8);
                    bf16_t* mp = MG + (size_t)(row0 + ai * HALF + m * 16) * 1024 + col0 + bj * HALF;
                    const f32x4 a0 = acc[ai][bj][m][0], a1 = acc[ai][bj][m][1];
                    float v[8] = {bf_lo(g.x) * a0[0], bf_hi(g.x) * a0[1], bf_lo(g.y) * a0[2], bf_hi(g.y) * a0[3], bf_lo(g.z) * a1[0], bf_hi(g.z) * a1[1], bf_lo(g.w) * a1[2], bf_hi(g.w) * a1[3]};
                    if (!first) { const u32x4 o = *(const u32x4*)mp;
                        v[0] += bf_lo(o.x); v[1] += bf_hi(o.x); v[2] += bf_lo(o.y); v[3] += bf_hi(o.y); v[4] += bf_lo(o.z); v[5] += bf_hi(o.z); v[6] += bf_lo(o.w); v[7] += bf_hi(o.w); }
                    u32x4 w; w.x = cvt_pk_bf16(v[0], v[1]); w.y = cvt_pk_bf16(v[2], v[3]); w.z = cvt_pk_bf16(v[4], v[5]); w.w = cvt_pk_bf16(v[6], v[7]);
                    *(u32x4*)mp = w;
                }
    }
};


struct EpiPart {
    static constexpr bool PERM = false, AFTER_DRAIN = false;
    float* P;
    __device__ __forceinline__ void operator()(const f32x4 (&acc)[2][2][4][2], const Unit& u, int wr, int wc, int fr, int fq) const {
        const int col0 = u.pn * BM + wc * 32 + 4 * fq;
#pragma unroll
        for (int ai = 0; ai < 2; ++ai)
#pragma unroll
            for (int m = 0; m < 4; ++m) {
                float* rp = P + (size_t)((u.pm - 64) * BM + ai * HALF + wr * 64 + m * 16 + fr) * 1024 + col0;
#pragma unroll
                for (int bj = 0; bj < 2; ++bj)
#pragma unroll
                    for (int n = 0; n < 2; ++n) *(f32x4*)(rp + bj * HALF + n * 16) = acc[ai][bj][m][n];
            }
    }
};
template <class Epi, class Sched, bool ALIGN_EPI = false, bool SP2 = false>
__device__ __forceinline__ void gemm_phase(PG8_LAS unsigned char* lds, const Gemm g, const Sched& S, const Epi& E) {
    const int tid = tid_now(), wid = __builtin_amdgcn_readfirstlane(tid >> 6), lane = tid & 63, wr = wid >> 2, wc = wid & 3, fr = lane & 15, fq = lane >> 4;
    const int K = g.K, nt = K / BK;
    unsigned voffA[2], voffB[2];
#pragma unroll
    for (int i = 0; i < 2; ++i) { int R, C; stage_rc(tid * 16 + i * 8192, R, C); const int Rb = Epi::PERM ? ((R & ~31) + perm32(R & 31)) : R;
        voffA[i] = (unsigned)(R * g.lda + C) * 2u; voffB[i] = (unsigned)(Rb * g.ldb + C) * 2u; }
    const size_t kstep = (size_t)(BK * 2);
    const size_t hsA = (size_t)HALF * g.lda * 2, hsB = (size_t)HALF * g.ldb * 2;
    const size_t tsA = 2 * hsA, tsB = 2 * hsB;
    const unsigned ldsw = (unsigned)wid * 1024u;
    const int aoff = lds_byte(wr * 64 + fr, fq * 8), boff = lds_byte(wc * 32 + fr, fq * 8);
#define PG8_SA(b, h) (((b) * 2 + (h)) * HTB)
#define PG8_SB(b, h) ((4 + (b) * 2 + (h)) * HTB)
#define PG8_STAGE(bufoff, gbase, voff) do { _Pragma("unroll") for (int _i = 0; _i < 2; ++_i) \
        __builtin_amdgcn_global_load_lds((const unsigned*)((const char*)(gbase) + (voff)[_i]), (PG8_LAS unsigned*)(lds + (bufoff) + ldsw + _i * 8192), 16, 0, 0); } while (0)
#define PG8_LDA(dst, b, h) do { _Pragma("unroll") for (int m = 0; m < 4; ++m) _Pragma("unroll") for (int k = 0; k < 2; ++k) dst[m][k] = *(const PG8_LAS bf16x8*)(lds + PG8_SA(b, h) + aoff + m * 2048 + k * 1024); } while (0)
#define PG8_LDB(dst, b, h) do { _Pragma("unroll") for (int n = 0; n < 2; ++n) _Pragma("unroll") for (int k = 0; k < 2; ++k) dst[n][k] = *(const PG8_LAS bf16x8*)(lds + PG8_SB(b, h) + boff + n * 2048 + k * 1024); } while (0)
#define PG8_MMA(ai, bj, At, Bt) do { __builtin_amdgcn_s_setprio(1); _Pragma("unroll") for (int m = 0; m < 4; ++m) _Pragma("unroll") for (int n = 0; n < 2; ++n) _Pragma("unroll") for (int k = 0; k < 2; ++k) \
        acc[ai][bj][m][n] = __builtin_amdgcn_mfma_f32_16x16x32_bf16(Bt[n][k], At[m][k], acc[ai][bj][m][n], 0, 0, 0); __builtin_amdgcn_s_setprio(0); } while (0)
#define PG8_WAIT_V(n) asm volatile("s_waitcnt vmcnt(" #n ")" ::: "memory")
#define PG8_WAIT_L(n) asm volatile("s_waitcnt lgkmcnt(" #n ")" ::: "memory")
#define PG8_BAR __builtin_amdgcn_s_barrier()
#define PG8_SCHED __builtin_amdgcn_sched_barrier(0)
    Unit cur, nxt; int ui = 0;
    if (!S.next(0, cur)) return;
    f32x4 acc[2][2][4][2];
#pragma unroll
    for (int a = 0; a < 2; ++a)
#pragma unroll
        for (int b = 0; b < 2; ++b)
#pragma unroll
            for (int m = 0; m < 4; ++m)
#pragma unroll
                for (int n = 0; n < 2; ++n) acc[a][b][m][n] = (f32x4){0.f, 0.f, 0.f, 0.f};
    bf16x8 At[4][2], B0[2][2], B1[2][2];
    const char* cA = (const char*)g.A + (size_t)cur.pm * tsA; const char* cB = (const char*)g.Bt + (size_t)cur.pn * tsB;
    S.a_ready(cur);
    if constexpr (SP2) {
        PG8_STAGE(PG8_SB(0, 0), cB, voffB); PG8_STAGE(PG8_SB(0, 1), cB + hsB, voffB); PG8_STAGE(PG8_SA(0, 0), cA, voffA); PG8_STAGE(PG8_SA(0, 1), cA + hsA, voffA);
        if (wr == 1) PG8_BAR;
        PG8_WAIT_V(2); PG8_BAR;
        PG8_STAGE(PG8_SB(1, 0), cB + kstep, voffB); PG8_STAGE(PG8_SA(1, 0), cA + kstep, voffA); PG8_STAGE(PG8_SB(1, 1), cB + hsB + kstep, voffB);
        PG8_WAIT_V(6); PG8_BAR;
    } else {
        PG8_STAGE(PG8_SB(0, 0), cB, voffB); PG8_STAGE(PG8_SA(0, 0), cA, voffA); PG8_STAGE(PG8_SB(0, 1), cB + hsB, voffB); PG8_STAGE(PG8_SA(0, 1), cA + hsA, voffA);
        if (wr == 1) PG8_BAR;
        PG8_WAIT_V(4); PG8_BAR;
        PG8_STAGE(PG8_SB(1, 0), cB + kstep, voffB); PG8_STAGE(PG8_SA(1, 0), cA + kstep, voffA); PG8_STAGE(PG8_SB(1, 1), cB + hsB + kstep, voffB);
        PG8_WAIT_V(6); PG8_BAR;
    }
    for (;;) {
        const bool has_next = S.next(ui + 1, nxt);
        const char* nA = has_next ? (const char*)g.A + (size_t)nxt.pm * tsA : cA; const char* nB = has_next ? (const char*)g.Bt + (size_t)nxt.pn * tsB : cB;
        for (int t = 0; t < nt; t += 2) {
            const bool last = (t == nt - 2);
            const char* a1 = cA + (size_t)(t + 1) * kstep;
            const char* a2 = last ? nA : cA + (size_t)(t + 2) * kstep; const char* b2 = last ? nB : cB + (size_t)(t + 2) * kstep;
            const char* a3 = a2 + kstep; const char* b3 = b2 + kstep;
            if (last && has_next) S.a_ready(nxt);
            if constexpr (SP2) {
            PG8_LDB(B0, 0, 0); PG8_LDB(B1, 0, 1); PG8_SCHED; PG8_LDA(At, 0, 0); PG8_STAGE(PG8_SA(1, 1), a1 + hsA, voffA);
            PG8_WAIT_V(8); PG8_WAIT_L(0); PG8_BAR; PG8_MMA(0, 0, At, B0); PG8_MMA(0, 1, At, B1); PG8_BAR; PG8_SCHED;
            PG8_LDA(At, 0, 1); PG8_STAGE(PG8_SB(0, 0), b2, voffB); PG8_STAGE(PG8_SB(0, 1), b2 + hsB, voffB); PG8_STAGE(PG8_SA(0, 0), a2, voffA);
            PG8_WAIT_V(8); PG8_WAIT_L(0); PG8_BAR; PG8_MMA(1, 0, At, B0); PG8_MMA(1, 1, At, B1); PG8_BAR; PG8_SCHED;
            PG8_LDB(B0, 1, 0); PG8_LDB(B1, 1, 1); PG8_SCHED; PG8_LDA(At, 1, 0); PG8_STAGE(PG8_SA(0, 1), a2 + hsA, voffA);
            PG8_WAIT_V(8); PG8_WAIT_L(0); PG8_BAR; PG8_MMA(0, 0, At, B0); PG8_MMA(0, 1, At, B1); PG8_BAR; PG8_SCHED;
            PG8_LDA(At, 1, 1); PG8_STAGE(PG8_SB(1, 0), b3, voffB); PG8_STAGE(PG8_SB(1, 1), b3 + hsB, voffB); PG8_STAGE(PG8_SA(1, 0), a3, voffA);
            PG8_WAIT_V(8); PG8_WAIT_L(0); PG8_BAR; PG8_MMA(1, 0, At, B0); PG8_MMA(1, 1, At, B1); PG8_BAR; PG8_SCHED;
            } else {
            PG8_LDB(B0, 0, 0); PG8_SCHED; PG8_LDA(At, 0, 0); PG8_STAGE(PG8_SA(1, 1), a1 + hsA, voffA);
            PG8_WAIT_L(8); PG8_BAR; PG8_WAIT_L(0); PG8_MMA(0, 0, At, B0); PG8_BAR; PG8_SCHED;
            PG8_LDB(B1, 0, 1); PG8_STAGE(PG8_SB(0, 0), b2, voffB);
            PG8_BAR; PG8_WAIT_L(0); PG8_MMA(0, 1, At, B1); PG8_BAR;
            PG8_LDA(At, 0, 1); PG8_STAGE(PG8_SA(0, 0), a2, voffA);
            PG8_BAR; PG8_WAIT_L(0); PG8_MMA(1, 0, At, B0); PG8_BAR; PG8_SCHED;
            PG8_STAGE(PG8_SB(0, 1), b2 + hsB, voffB);
            PG8_WAIT_V(6); PG8_BAR; PG8_MMA(1, 1, At, B1); PG8_BAR;
            PG8_LDB(B0, 1, 0); PG8_SCHED; PG8_LDA(At, 1, 0); PG8_STAGE(PG8_SA(0, 1), a2 + hsA, voffA);
            PG8_WAIT_L(8); PG8_BAR; PG8_WAIT_L(0); PG8_MMA(0, 0, At, B0); PG8_BAR; PG8_SCHED;
            PG8_LDB(B1, 1, 1); PG8_STAGE(PG8_SB(1, 0), b3, voffB);
            PG8_BAR; PG8_WAIT_L(0); PG8_MMA(0, 1, At, B1); PG8_BAR;
            PG8_LDA(At, 1, 1); PG8_STAGE(PG8_SA(1, 0), a3, voffA);
            PG8_BAR; PG8_WAIT_L(0); PG8_MMA(1, 0, At, B0); PG8_BAR; PG8_SCHED;
            PG8_STAGE(PG8_SB(1, 1), b3 + hsB, voffB);
            PG8_WAIT_V(6); PG8_BAR; PG8_MMA(1, 1, At, B1); PG8_BAR;
            }
        }
        if constexpr (ALIGN_EPI) { if (wr == 0) PG8_BAR; }
        if constexpr (!Epi::AFTER_DRAIN) { E(acc, cur, wr, wc, fr, fq); S.done(cur); }
        if (!has_next) break;
#pragma unroll
        for (int a = 0; a < 2; ++a)
#pragma unroll
            for (int b = 0; b < 2; ++b)
#pragma unroll
                for (int m = 0; m < 4; ++m)
#pragma unroll
                    for (int n = 0; n < 2; ++n) acc[a][b][m][n] = (f32x4){0.f, 0.f, 0.f, 0.f};
        cur = nxt; cA = nA; cB = nB; ++ui;
        if constexpr (ALIGN_EPI) { if (wr == 1) PG8_BAR; }
    }
    PG8_WAIT_V(0);
    if constexpr (!ALIGN_EPI) { if (wr == 0) PG8_BAR; }
    PG8_BAR;
    if constexpr (Epi::AFTER_DRAIN) { E.fused(acc, cur, wr, wc, fr, fq, lds, wid, lane); S.done(cur); }
#undef PG8_SA
#undef PG8_SB
#undef PG8_STAGE
#undef PG8_LDA
#undef PG8_LDB
#undef PG8_MMA
#undef PG8_WAIT_V
#undef PG8_WAIT_L
#undef PG8_BAR
#undef PG8_SCHED
}
}
namespace attn_body {
using bf16=__hip_bfloat16;
using bf16x8=__attribute__((ext_vector_type(8)))short;
using s16x4=__attribute__((ext_vector_type(4)))short;
using f32x16=__attribute__((ext_vector_type(16)))float;
using u32x4=__attribute__((ext_vector_type(4)))unsigned;
constexpr int D=64,QP=3328,OP=1024;
constexpr int NW=8,QBLK=32,QB=QBLK*NW,KVBLK=64;
constexpr int ATTN_UNIT_ROWS=QB;
__device__ __forceinline__ int crow(int r,int hi){return (r&3)+8*(r>>2)+4*hi;}
#define SBAR() __builtin_amdgcn_sched_barrier(0)
__device__ __forceinline__ void cmask(f32x16&p0,f32x16&p1,int jb,int qrel,int hi){
  const float NEG=-INFINITY; int kb=64*jb+4*hi;
  #pragma unroll
  for(int r=0;r<16;++r){int kv=kb+(r&3)+8*(r>>2); if(kv>qrel)p0[r]=NEG; if(kv+32>qrel)p1[r]=NEG;}
}

constexpr int NSLOT=3, SLOTB=8192;
constexpr int LDS_K=0, LDS_V=NSLOT*SLOTB, LDS_WS=2*NSLOT*SLOTB, LDS_OST=LDS_WS+NW*64*4, LDS_BYTES=LDS_OST+NW*4096;
constexpr float C2=0.125f*1.4426950408889634f;
__device__ __forceinline__ void glds16(const void*gsrc,unsigned lds_dst){unsigned keep;
  asm volatile("s_mov_b32 %0, m0\n\ts_mov_b32 m0, %2\n\ts_nop 0\n\tglobal_load_lds_dwordx4 %1, off\n\ts_mov_b32 m0, %0":"=&s"(keep):"v"(gsrc),"s"(lds_dst):"memory");}
__device__ __forceinline__ float max3f(float a,float b,float c){float r;asm("v_max3_f32 %0, %1, %2, %3":"=v"(r):"v"(a),"v"(b),"v"(c));return r;}
__device__ __forceinline__ float max2f(float a,float b){float r;asm("v_max_f32_e32 %0, %1, %2":"=v"(r):"v"(a),"v"(b));return r;}
__device__ __forceinline__ float fadd_s(float a,float b){float r;asm("v_add_f32_e32 %0, %1, %2":"=v"(r):"v"(a),"v"(b));return r;}
__device__ __forceinline__ float fsub_s(float a,float b){float r;asm("v_sub_f32_e32 %0, %1, %2":"=v"(r):"v"(a),"v"(b));return r;}
typedef float f32x2_t __attribute__((ext_vector_type(2))); typedef __bf16 bf16x2_t __attribute__((ext_vector_type(2)));
__device__ __forceinline__ unsigned cvtpk_s(float lo,float hi){f32x2_t v={lo,hi};bf16x2_t b=__builtin_convertvector(v,bf16x2_t);return __builtin_bit_cast(unsigned,b);}
#define WAIT_BAR(N) asm volatile("s_waitcnt vmcnt(" #N ") lgkmcnt(0)\n\ts_barrier":::"memory")

__device__ __forceinline__ void qkt(f32x16&p0,f32x16&p1,const char*Kslot,const bf16x8*qr,const f32x16&negm,int r32,int hi){
  const char*kb=Kslot+hi*1024+r32*16;
  #pragma unroll
  for(int d0=0;d0<4;++d0){
    const bf16x8 b0=*reinterpret_cast<const bf16x8*>(kb+d0*2048);
    const bf16x8 b1=*reinterpret_cast<const bf16x8*>(kb+d0*2048+512);
    if(d0==0){p0=__builtin_amdgcn_mfma_f32_32x32x16_bf16(b0,qr[0],negm,0,0,0);p1=__builtin_amdgcn_mfma_f32_32x32x16_bf16(b1,qr[0],negm,0,0,0);}
    else{p0=__builtin_amdgcn_mfma_f32_32x32x16_bf16(b0,qr[d0],p0,0,0,0);p1=__builtin_amdgcn_mfma_f32_32x32x16_bf16(b1,qr[d0],p1,0,0,0);}}
}
typedef __attribute__((address_space(3))) const char* lds_cptr;
typedef short v4i16_t __attribute__((ext_vector_type(4)));
__device__ __forceinline__ void kload8(bf16x8*kf,lds_cptr kp){
  kf[0]=*(const __attribute__((address_space(3))) bf16x8*)(kp);      kf[1]=*(const __attribute__((address_space(3))) bf16x8*)(kp+512);
  kf[2]=*(const __attribute__((address_space(3))) bf16x8*)(kp+2048); kf[3]=*(const __attribute__((address_space(3))) bf16x8*)(kp+2560);
  kf[4]=*(const __attribute__((address_space(3))) bf16x8*)(kp+4096); kf[5]=*(const __attribute__((address_space(3))) bf16x8*)(kp+4608);
  kf[6]=*(const __attribute__((address_space(3))) bf16x8*)(kp+6144); kf[7]=*(const __attribute__((address_space(3))) bf16x8*)(kp+6656);
}
__device__ __forceinline__ void kload2(bf16x8*kf,lds_cptr kp,int j){ kf[2*j]=*(const __attribute__((address_space(3))) bf16x8*)(kp+j*2048); kf[2*j+1]=*(const __attribute__((address_space(3))) bf16x8*)(kp+j*2048+512); }
__device__ __forceinline__ s16x4 vtr(lds_cptr p){ return __builtin_bit_cast(s16x4,__builtin_amdgcn_ds_read_tr16_b64_v4i16((__attribute__((address_space(3))) v4i16_t*)p)); }
__device__ __forceinline__ float rowmax(const f32x16&p0,const f32x16&p1){
  float a=max3f(p0[0],p0[1],p1[0]),b=max3f(p0[2],p0[3],p1[1]);a=max3f(a,p1[2],p1[3]);
  #pragma unroll
  for(int r=4;r<16;r+=4){a=max3f(a,p0[r],p0[r+1]);b=max3f(b,p0[r+2],p0[r+3]);a=max3f(a,p1[r],p1[r+1]);b=max3f(b,p1[r+2],p1[r+3]);}
  const float m=max2f(a,b);
  auto rr=__builtin_amdgcn_permlane32_swap(__float_as_uint(m),__float_as_uint(m),false,false);
  return max2f(__uint_as_float(rr[0]),__uint_as_float(rr[1]));
}
__device__ __forceinline__ void pv(f32x16*o,int vb,bf16x8 pa0,bf16x8 pa1,bf16x8 pa2,bf16x8 pa3){
  #pragma unroll
  for(int d0=0;d0<2;++d0){s16x4 lo[4],hi[4];
    #pragma unroll
    for(int ks=0;ks<4;++ks){
      asm volatile("ds_read_b64_tr_b16 %0,%1 offset:%c2":"=&v"(lo[ks]):"v"(vb),"i"(d0*4096+ks*1024):"memory");
      asm volatile("ds_read_b64_tr_b16 %0,%1 offset:%c2":"=&v"(hi[ks]):"v"(vb),"i"(d0*4096+ks*1024+512):"memory");}
    asm volatile("s_waitcnt lgkmcnt(0)":::"memory");SBAR();
    #define PK(k) (bf16x8){lo[k][0],lo[k][1],lo[k][2],lo[k][3],hi[k][0],hi[k][1],hi[k][2],hi[k][3]}
    o[d0]=__builtin_amdgcn_mfma_f32_32x32x16_bf16(pa0,PK(0),o[d0],0,0,0);
    o[d0]=__builtin_amdgcn_mfma_f32_32x32x16_bf16(pa1,PK(1),o[d0],0,0,0);
    o[d0]=__builtin_amdgcn_mfma_f32_32x32x16_bf16(pa2,PK(2),o[d0],0,0,0);
    o[d0]=__builtin_amdgcn_mfma_f32_32x32x16_bf16(pa3,PK(3),o[d0],0,0,0);
    #undef PK
  }
}

#ifndef ATTN_STORE16
#define ATTN_STORE16(p,v) (*(u32x4*)(p)=(v))
#endif
template<int THRL> __device__ __forceinline__ void attn_unit(const bf16*Qu,const bf16*__restrict__ Kc,const bf16*__restrict__ Vc,bf16*Ou,int krow0,int nt_main,int krow1,int NT,char*shm){
  const int tid=tid_now(),lane=tid&63,r32=lane&31,hi=lane>>5; const int wid=__builtin_amdgcn_readfirstlane(tid>>6);
  const bf16*Qw=Qu+(long)(wid*QBLK)*QP;
  const unsigned lds0=(unsigned)(uintptr_t)shm;
  float*wsf=(float*)(shm+LDS_WS)+wid*64;
  const bf16*ksrc=Kc+(long)lane*QP+wid*8;
  const bf16*vsrc=Vc+(long)(16*(wid&3)+(lane>>2))*QP+(wid>>2)*32+(lane&3)*8;
  const unsigned kdst=lds0+LDS_K+wid*1024, vdst=lds0+LDS_V+wid*1024;
  #define KROW(t) (((t)<nt_main)?(krow0+(t)*KVBLK):(krow1+((t)-nt_main)*KVBLK))
  #define DMA_K(t,slot) glds16(ksrc+(long)KROW(t)*QP,(unsigned)__builtin_amdgcn_readfirstlane(kdst+(slot)))
  #define DMA_V(t,slot) glds16(vsrc+(long)KROW(t)*QP,(unsigned)__builtin_amdgcn_readfirstlane(vdst+(slot)))
  const int vb0=(int)(lds0+LDS_V)+((lane>>4)&1)*32+(lane&3)*8+(4*hi+((lane&15)>>2))*64;
  const char*Kbase=shm+LDS_K; bf16x8 kf[8];
  const lds_cptr shm3=(lds_cptr)shm; const lds_cptr kp0=shm3+LDS_K+hi*1024+r32*16; const lds_cptr vp0=shm3+LDS_V+((lane>>4)&1)*32+(lane&3)*8+(4*hi+((lane&15)>>2))*64;
  DMA_K(0,0);DMA_V(0,0);DMA_K(1,SLOTB);
  bf16x8 qr[4];
  #pragma unroll
  for(int d0=0;d0<4;++d0)qr[d0]=*reinterpret_cast<const bf16x8*>(&Qw[(long)r32*QP+d0*16+hi*8]);
  float mhat=0.f,l_reg=0.f;f32x16 o[2];o[0]=f32x16{};o[1]=f32x16{};f32x16 negm=f32x16{};asm volatile("":"+v"(negm));
  const int qrel=wid*QBLK+r32;
  #define CMASK(P0,P1,t) do{}while(0)
  bool resc=false;
  #define START(P0,P1) do{ const float rm=rowmax(P0,P1); resc=false; \
    { const float dl=rm; mhat=fadd_s(mhat,dl); \
      _Pragma("unroll") for(int r=0;r<16;++r){P0[r]=fsub_s(P0[r],dl);P1[r]=fsub_s(P1[r],dl);} \
      _Pragma("unroll") for(int r=0;r<16;++r)negm[r]=-mhat; asm volatile("":"+v"(negm)); } \
    _Pragma("unroll") for(int r=0;r<16;++r)P0[r]=__builtin_amdgcn_exp2f(P0[r]); }while(0)
  #define RESC() do{ if(resc){ asm volatile("s_waitcnt lgkmcnt(0)":::"memory"); \
      _Pragma("unroll") for(int d_=0;d_<2;++d_) _Pragma("unroll") for(int r=0;r<16;++r)o[d_][r]*=wsf[crow(r,hi)]; } }while(0)
  f32x16 pA0,pA1,pB0,pB1;
  int sl_prev=0,sl_cur=0,sl_next=SLOTB;
  #define ROT() do{sl_prev=sl_cur;sl_cur=sl_next;sl_next=(sl_next==(NSLOT-1)*SLOTB)?0:sl_next+SLOTB;}while(0)
  DMA_K(2,2*SLOTB);
  WAIT_BAR(3);
  qkt(pA0,pA1,Kbase,qr,negm,r32,hi);asm volatile("s_nop 15\n\ts_nop 7":"+v"(pA0),"+v"(pA1));CMASK(pA0,pA1,0);
  START(pA0,pA1);
  _Pragma("unroll") for(int r=0;r<16;++r)pA1[r]=__builtin_amdgcn_exp2f(pA1[r]);
  WAIT_BAR(0);
  DMA_K(3,0);DMA_V(1,SLOTB);
  ROT();
  kload8(kf,kp0+sl_cur);
  WAIT_BAR(2);
  s16x4 vlo[8],vhi[8]; u32x4 pw0,pw1,pw2,pw3;
  #define PKW(P,B) cvtpk_s(P[B],P[B+1])
  #define PAF(k) __builtin_bit_cast(bf16x8,pw##k)
  #define VFR(i) (bf16x8){vlo[i][0],vlo[i][1],vlo[i][2],vlo[i][3],vhi[i][0],vhi[i][1],vhi[i][2],vhi[i][3]}
  #define PIN(x) asm volatile("":"+v"(x))
  #define MX3(a,b,c) __builtin_fmaxf(__builtin_fmaxf((a),(b)),(c))
  #define GAPA(MF,A0,A1,A2,A3,W0,W1,PW) do{ MF; sacc+=A0; sacc+=A1; sacc+=A2; sacc+=A3; PIN(sacc); W0; W1; PIN(PW); SBAR(); }while(0)
  #define EX(v) __builtin_amdgcn_exp2f(v)
  #define GAPB(MF,X,B) do{ MF; X[B]=EX(X[B]); X[B+1]=EX(X[B+1]); X[B+2]=EX(X[B+2]); X[B+3]=EX(X[B+3]); PIN(X); SBAR(); }while(0)
  #define VRD(i) do{ vlo[i]=vtr(vp_+(((i)>>2)*4096+((i)&3)*1024)); vhi[i]=vtr(vp_+(((i)>>2)*4096+((i)&3)*1024+512)); }while(0)
  #define KRD(G,j) do{ if(G){ kload2(kf,kp0+sl_next,j); SBAR(); } }while(0)
  #define STEP(C0,C1,P0,P1,t,GK,GV,GL) do{ SBAR(); \
    const lds_cptr vp_=vp0+sl_prev; \
    VRD(0); SBAR(); float sacc=(P0[0]+P0[1]); \
    GAPA(C0=__builtin_amdgcn_mfma_f32_32x32x16_bf16(kf[0],qr[0],negm,0,0,0), P0[2],P0[3],P0[4],P0[5],     pw0[0]=PKW(P0,0), pw0[1]=PKW(P0,2), pw0); \
    VRD(4); SBAR(); GAPA(C1=__builtin_amdgcn_mfma_f32_32x32x16_bf16(kf[1],qr[0],negm,0,0,0), P0[6],P0[7],P0[8],P0[9],     pw0[2]=PKW(P0,4), pw0[3]=PKW(P0,6), pw0); \
    VRD(1); SBAR(); GAPA(C0=__builtin_amdgcn_mfma_f32_32x32x16_bf16(kf[2],qr[1],C0,0,0,0),   P0[10],P0[11],P0[12],P0[13], pw1[0]=PKW(P0,8), pw1[1]=PKW(P0,10), pw1); \
    VRD(5); SBAR(); GAPA(C1=__builtin_amdgcn_mfma_f32_32x32x16_bf16(kf[3],qr[1],C1,0,0,0),   P0[14],P0[15],P1[0],P1[1],   pw1[2]=PKW(P0,12),pw1[3]=PKW(P0,14), pw1); \
    VRD(2); SBAR(); GAPA(C0=__builtin_amdgcn_mfma_f32_32x32x16_bf16(kf[4],qr[2],C0,0,0,0),   P1[2],P1[3],P1[4],P1[5],     pw2[0]=PKW(P1,0), pw2[1]=PKW(P1,2), pw2); \
    VRD(6); SBAR(); GAPA(C1=__builtin_amdgcn_mfma_f32_32x32x16_bf16(kf[5],qr[2],C1,0,0,0),   P1[6],P1[7],P1[8],P1[9],     pw2[2]=PKW(P1,4), pw2[3]=PKW(P1,6), pw2); \
    VRD(3); SBAR(); GAPA(C0=__builtin_amdgcn_mfma_f32_32x32x16_bf16(kf[6],qr[3],C0,0,0,0),   P1[10],P1[11],P1[12],P1[13], pw3[0]=PKW(P1,8), pw3[1]=PKW(P1,10), pw3); \
    VRD(7); SBAR(); GAPA(C1=__builtin_amdgcn_mfma_f32_32x32x16_bf16(kf[7],qr[3],C1,0,0,0),   P1[14],P1[15],0.f,0.f,       pw3[2]=PKW(P1,12),pw3[3]=PKW(P1,14), pw3); \
    l_reg+=sacc; \
    if(GK){DMA_K((t)+3,sl_cur);} if(GV){DMA_V((t)+1,sl_next);} \
    CMASK(C0,C1,t); \
    { float a=MX3(C0[0],C0[1],C1[0]),b=MX3(C0[2],C0[3],C1[1]); a=MX3(a,C1[2],C1[3]); \
      _Pragma("unroll") for(int r=4;r<16;r+=4){a=MX3(a,C0[r],C0[r+1]);b=MX3(b,C0[r+2],C0[r+3]);a=MX3(a,C1[r],C1[r+1]);b=MX3(b,C1[r+2],C1[r+3]);} \
      float rm=__builtin_fmaxf(a,b); { auto rr=__builtin_amdgcn_permlane32_swap(__float_as_uint(rm),__float_as_uint(rm),false,false); rm=__builtin_fmaxf(__uint_as_float(rr[0]),__uint_as_float(rr[1])); } \
      resc=false; \
      if(__builtin_expect(__any(rm>(float)THRL),0)){ const float dl=__builtin_fmaxf(rm,0.f); mhat+=dl; \
        _Pragma("unroll") for(int r=0;r<16;++r){C0[r]-=dl;C1[r]-=dl;} \
        _Pragma("unroll") for(int r=0;r<16;++r)negm[r]=-mhat; asm volatile("":"+v"(negm)); \
        const float f=__builtin_amdgcn_exp2f(-dl); l_reg*=f; if(hi==0)wsf[r32]=f; resc=true; } } \
    SBAR(); \
    GAPB(o[0]=__builtin_amdgcn_mfma_f32_32x32x16_bf16(PAF(0),VFR(0),o[0],0,0,0), C0,0); \
    GAPB(o[1]=__builtin_amdgcn_mfma_f32_32x32x16_bf16(PAF(0),VFR(4),o[1],0,0,0), C0,4); \
    KRD(GL,0); GAPB(o[0]=__builtin_amdgcn_mfma_f32_32x32x16_bf16(PAF(1),VFR(1),o[0],0,0,0), C0,8); \
    KRD(GL,1); GAPB(o[1]=__builtin_amdgcn_mfma_f32_32x32x16_bf16(PAF(1),VFR(5),o[1],0,0,0), C0,12); \
    KRD(GL,2); GAPB(o[0]=__builtin_amdgcn_mfma_f32_32x32x16_bf16(PAF(2),VFR(2),o[0],0,0,0), C1,0); \
    KRD(GL,3); GAPB(o[1]=__builtin_amdgcn_mfma_f32_32x32x16_bf16(PAF(2),VFR(6),o[1],0,0,0), C1,4); \
    GAPB(o[0]=__builtin_amdgcn_mfma_f32_32x32x16_bf16(PAF(3),VFR(3),o[0],0,0,0), C1,8); \
    GAPB(o[1]=__builtin_amdgcn_mfma_f32_32x32x16_bf16(PAF(3),VFR(7),o[1],0,0,0), C1,12); \
    }while(0)
  int t=1;
  #undef CMASK
  #define CMASK(P0,P1,t) do{}while(0)
  for(;t+5<NT;t+=2){
    STEP(pB0,pB1,pA0,pA1,t,true,true,true);     WAIT_BAR(2); RESC(); ROT();
    STEP(pA0,pA1,pB0,pB1,t+1,true,true,true);   WAIT_BAR(2); RESC(); ROT();
  }
  #undef CMASK
  #define CMASK(P0,P1,t) do{}while(0)
  #define ENDW(tt) do{ if((tt)+3<NT){WAIT_BAR(2);} else if((tt)+2<NT){WAIT_BAR(1);} else {WAIT_BAR(0);} }while(0)
  for(;t+1<NT;t+=2){
    STEP(pB0,pB1,pA0,pA1,t,(t+3<NT),(t+1<NT),(t+1<NT));       ENDW(t);   RESC(); ROT();
    STEP(pA0,pA1,pB0,pB1,t+1,(t+4<NT),(t+2<NT),(t+2<NT));     ENDW(t+1); RESC(); ROT();
  }
  STEP(pB0,pB1,pA0,pA1,NT-1,false,false,false); RESC();
  { float sacc=pB0[0]+pB0[1]; _Pragma("unroll") for(int r=2;r<16;++r)sacc+=pB0[r]; _Pragma("unroll") for(int r=0;r<16;++r)sacc+=pB1[r]; l_reg+=sacc;
    pw0=(u32x4){PKW(pB0,0),PKW(pB0,2),PKW(pB0,4),PKW(pB0,6)};pw1=(u32x4){PKW(pB0,8),PKW(pB0,10),PKW(pB0,12),PKW(pB0,14)};pw2=(u32x4){PKW(pB1,0),PKW(pB1,2),PKW(pB1,4),PKW(pB1,6)};pw3=(u32x4){PKW(pB1,8),PKW(pB1,10),PKW(pB1,12),PKW(pB1,14)};
    SBAR(); pv(o,vb0+sl_cur,PAF(0),PAF(1),PAF(2),PAF(3)); }
  #undef PKW
  #undef PAF
  #undef VFR
  #undef PIN
  #undef MX3
  #undef GAPA
  #undef GAPB
  #undef EX
  #undef VRD
  #undef KRD
  #undef STEP
  #undef ENDW
  {auto rr=__builtin_amdgcn_permlane32_swap(__float_as_uint(l_reg),__float_as_uint(l_reg),false,false);l_reg=__uint_as_float(rr[0])+__uint_as_float(rr[1]);}
  if(hi==0)wsf[32+r32]=l_reg;asm volatile("s_waitcnt lgkmcnt(0)":::"memory");
  float rli[16];
  #pragma unroll
  for(int r=0;r<16;++r)rli[r]=__builtin_amdgcn_rcpf(wsf[32+crow(r,hi)]);
  bf16*Ow=Ou+(long)(wid*QBLK)*OP;
  { bf16*stg=(bf16*)(shm+LDS_OST)+wid*2048;
    #pragma unroll
    for(int r=0;r<16;++r){const int orow=crow(r,hi);
      #pragma unroll
      for(int d0=0;d0<2;++d0)stg[orow*64+d0*32+r32]=__float2bfloat16(o[d0][r]*rli[r]);}
    asm volatile("s_waitcnt lgkmcnt(0)":::"memory");
    #pragma unroll
    for(int i=0;i<4;++i){const int row=i*8+(lane>>3),ch=lane&7; const u32x4 v=*(const u32x4*)(stg+row*64+ch*8); ATTN_STORE16(Ow+(long)row*OP+ch*8,v);} }
  asm volatile("s_waitcnt lgkmcnt(0)\n\ts_barrier":::"memory");
  #undef DMA_K
  #undef KROW
  #undef DMA_V
  #undef CMASK
  #undef START
  #undef RESC
  #undef ROT
}
constexpr int ATTN_LDS_BYTES=LDS_BYTES;
#undef SBAR
#undef WAIT_BAR
}

#define LAS __attribute__((address_space(3)))
typedef unsigned short bf16;
typedef float f32x4 __attribute__((ext_vector_type(4)));
typedef unsigned u32x4 __attribute__((ext_vector_type(4)));
typedef unsigned u32x2 __attribute__((ext_vector_type(2)));
using pg8::cvt_pk_bf16; using pg8::bf_lo; using pg8::bf_hi; using pg8::fsigmoid; using pg8::fsilu;

constexpr int NWAVES = 8, NTHR = 512;
constexpr int DM = 1024, NX = 16384, NCTX = 1024, MT = NX + NCTX, SEQ = 4096, CTXL = 256, FF = 2816, PXW = 3328, MODW = 9216, INC = 7424;
constexpr int A_OFF = 0, B_OFF = 768, Q_OFF = 1280, K_OFF = 1792, V_OFF = 2304, D_OFF = 2816, G_OFF = 3328;
constexpr float EPS = 1e-6f;
constexpr float C2 = 0.125f * 1.4426950408889634f;
constexpr int LDS_BYTES = 147456;

constexpr size_t MiB = 1u << 20;
constexpr size_t WS_MOD = 0;
constexpr size_t WS_ROPE = 512 * 1024;
constexpr size_t WS_LAM = WS_ROPE + 16384;
constexpr size_t WS_BAR = 640 * 1024;
constexpr size_t WS_W = 1 * MiB;
constexpr size_t LW_UP1 = 0, LW_DN1 = LW_UP1 + (size_t)5632 * 1024, LW_UP2 = LW_DN1 + (size_t)1024 * 2816, LW_DN2 = LW_UP2 + (size_t)5632 * 1024,
                 LW_WIN = LW_DN2 + (size_t)1024 * 2816, LW_AO = LW_WIN + (size_t)INC * 1024, LW_BO = LW_AO + 262144, LW_DO = LW_BO + 262144,
                 LW_CO = LW_DO + 262144, LW_O = LW_CO + 524288, LW_TOTAL = LW_O + 1048576;
static_assert(LW_TOTAL * 2 == 52 * MiB, "weights per layer");
constexpr size_t WS_HN = 105 * MiB;
constexpr size_t WS_PX = 139 * MiB;
constexpr size_t WS_OB = 250 * MiB;
constexpr size_t WS_GS = 284 * MiB;
constexpr size_t WS_ACTD = 316 * MiB;
constexpr size_t WS_CTX = 325 * MiB;
constexpr size_t WS_MGP = 329 * MiB;
constexpr size_t WS_END = 337 * MiB;
constexpr size_t WS_PART = WS_GS;
static_assert(WS_HN + (size_t)MT * 1024 * 2 <= WS_PX && WS_PX + (size_t)MT * PXW * 2 <= WS_OB && WS_OB + (size_t)MT * 1024 * 2 <= WS_GS && WS_ACTD + (size_t)MT * 256 * 2 <= WS_CTX, "ws map");

#define GAS __attribute__((address_space(1)))
#define XB_TMO      128
#define XB_XCNT(j)  (256  + 64 * (j))
#define XB_XSUB(j)  (1280 + 64 * (j))
#define XB_XGEN(j)  (2304 + 64 * (j))
#define XB_TOP      3328
#define XB_TOPGEN   3392
#define XCD_BAR_WORDS 3456
#define XB_SPIN_CAP (1u << 18)

__device__ __forceinline__ unsigned xb_ld(unsigned* p)              { return __hip_atomic_load(p, __ATOMIC_RELAXED, __HIP_MEMORY_SCOPE_AGENT); }
__device__ __forceinline__ unsigned xb_add(unsigned* p, unsigned v) { return __hip_atomic_fetch_add(p, v, __ATOMIC_RELAXED, __HIP_MEMORY_SCOPE_AGENT); }
__device__ __forceinline__ unsigned xb_xcc_id() { return (unsigned)__builtin_amdgcn_s_getreg((3 << 11) | 20) & 0xFu; }
#define XB_SPIN(cond, bar) do { unsigned _sp = 0; while (cond) { __builtin_amdgcn_s_sleep(1); \
    if ((++_sp & 255u) == 0u) { if (xb_ld(&(bar)[XB_TMO])) break; if (_sp > XB_SPIN_CAP) { atomicAdd(&(bar)[XB_TMO], 1u); break; } } } } while (0)

struct XcdBarrier {
    unsigned* bar; unsigned x;
    volatile LAS unsigned* st;
};

__device__ __forceinline__ XcdBarrier xcd_barrier_post(unsigned* bar, volatile LAS unsigned* st) {
    XcdBarrier b; b.bar = bar; b.x = xb_xcc_id(); b.st = st;
    if (threadIdx.x == 0) (void)xb_add(&bar[XB_XCNT(b.x)], 1u);
    return b;
}
__device__ __forceinline__ void xcd_barrier_complete(unsigned* bar, unsigned x, unsigned& nloc, unsigned& nx) {
    const unsigned G = gridDim.x * gridDim.y * gridDim.z;
    unsigned sum, cnt, mine, sp = 0u;
    for (;;) {
        sum = 0u; cnt = 0u; mine = 0u;
#pragma unroll
        for (unsigned j = 0; j < 16; ++j) { const unsigned c = xb_ld(&bar[XB_XCNT(j)]); sum += c; cnt += (c > 0u) ? 1u : 0u; mine = (j == x) ? c : mine; }
        if (sum == G) break;
        __builtin_amdgcn_s_sleep(1);
        if ((++sp & 255u) == 0u) { if (xb_ld(&bar[XB_TMO])) break; if (sp > XB_SPIN_CAP) { atomicAdd(&bar[XB_TMO], 1u); break; } }
    }
    nloc = mine > 0u ? mine : 1u; nx = cnt > 0u ? cnt : 1u;
}

__device__ __forceinline__ void xcd_barrier(const XcdBarrier& b) {
    asm volatile("s_waitcnt vmcnt(0)" ::: "memory");
    __syncthreads();
    if (threadIdx.x == 0) {
        unsigned* bar = b.bar;
        __builtin_amdgcn_s_waitcnt(0);
        unsigned nloc = b.st[0], nx = b.st[1];
        if (nloc == 0u) { xcd_barrier_complete(bar, b.x, nloc, nx); b.st[0] = nloc; b.st[1] = nx; }
        const unsigned old = xb_add(&bar[XB_XSUB(b.x)], 1u);
        const unsigned gen = old / nloc;
        if (old + 1u == (gen + 1u) * nloc) {
            __builtin_amdgcn_fence(__ATOMIC_RELEASE, "agent");
            asm volatile("s_waitcnt vmcnt(0)" ::: "memory");
            const unsigned og = xb_add(&bar[XB_TOP], 1u);
            const unsigned tg = og / nx;
            if (og + 1u == (tg + 1u) * nx) xb_add(&bar[XB_TOPGEN], 1u);
            else XB_SPIN(xb_ld(&bar[XB_TOPGEN]) == tg, bar);
            __builtin_amdgcn_fence(__ATOMIC_ACQUIRE, "agent");
            xb_add(&bar[XB_XGEN(b.x)], 1u);
            asm volatile("s_waitcnt vmcnt(0)" ::: "memory");
        } else {
            XB_SPIN(xb_ld(&bar[XB_XGEN(b.x)]) == gen, bar);
            __builtin_amdgcn_fence(__ATOMIC_ACQUIRE, "agent");
            asm volatile("s_waitcnt vmcnt(0)" ::: "memory");
        }
    }
    __syncthreads();
}

struct Params { const float* in[29]; float* out; unsigned char* ws; int ph_lo, ph_hi; };
typedef __attribute__((address_space(4))) const Params* KP;

__device__ __forceinline__ float wave_sum(float v) {
#pragma unroll
    for (int o = 1; o < 64; o <<= 1) v += __shfl_xor(v, o);
    return v;
}

__device__ __forceinline__ void transpose_item(const float* W, int K, int N, bf16* WT, LAS float* scr, int k0, int n0, int drow0, int lane) {
#pragma unroll 8
    for (int i = 0; i < 32; ++i) { const int kk = 2 * i + (lane >> 5); scr[kk * 33 + (lane & 31)] = W[(size_t)(k0 + kk) * N + n0 + (lane & 31)]; }
    asm volatile("s_waitcnt lgkmcnt(0)" ::: "memory");
    const int c = lane & 7;
#pragma unroll
    for (int j = 0; j < 4; ++j) { const int n = (lane >> 3) + 8 * j; const LAS float* s = scr + (8 * c) * 33 + n;
        u32x4 o; o.x = cvt_pk_bf16(s[0 * 33], s[1 * 33]); o.y = cvt_pk_bf16(s[2 * 33], s[3 * 33]); o.z = cvt_pk_bf16(s[4 * 33], s[5 * 33]); o.w = cvt_pk_bf16(s[6 * 33], s[7 * 33]);
        *(u32x4*)(WT + (size_t)(drow0 + n) * K + k0 + 8 * c) = o; }
    asm volatile("s_waitcnt lgkmcnt(0)" ::: "memory");
}
__device__ __forceinline__ bool transpose_mat(int& r, const float* W, int K, int N, bf16* WT, int mode, LAS float* scr, int lane) {
    const int nblk = N / 32, items = (K / 64) * nblk;
    if (r >= items) { r -= items; return false; }
    const int kb = r / nblk, nb = r % nblk, n0 = 32 * nb;
    const int drow0 = (mode == 0) ? n0 : (256 * (n0 >> 7) + (n0 & 127) + (mode == 2 ? 128 : 0));
    transpose_item(W, K, N, WT, scr, 64 * kb, n0, drow0, lane);
    return true;
}

__device__ __forceinline__ void convert_weights(KP pp, unsigned char* lds_g, int l, int widx, int nw, int lane, int wave) {
    LAS float* scr = (LAS float*)((LAS unsigned char*)lds_g + wave * 16384);
    constexpr int ITEMS_L = 13312;
    bf16* WB = (bf16*)(pp->ws + WS_W) + (size_t)l * LW_TOTAL;
    const size_t offf = (size_t)l * 1024 * 2816;
    for (int it = widx; it < ITEMS_L; it += nw) {
        int r = it;
        if (transpose_mat(r, pp->in[7] + offf, 1024, 2816, WB + LW_UP1, 1, scr, lane)) continue;
        if (transpose_mat(r, pp->in[8] + offf, 1024, 2816, WB + LW_UP1, 2, scr, lane)) continue;
        if (transpose_mat(r, pp->in[9] + offf, 2816, 1024, WB + LW_DN1, 0, scr, lane)) continue;
        if (transpose_mat(r, pp->in[10] + offf, 1024, 2816, WB + LW_UP2, 1, scr, lane)) continue;
        if (transpose_mat(r, pp->in[11] + offf, 1024, 2816, WB + LW_UP2, 2, scr, lane)) continue;
        if (transpose_mat(r, pp->in[12] + offf, 2816, 1024, WB + LW_DN2, 0, scr, lane)) continue;
        if (transpose_mat(r, pp->in[13] + (size_t)l * 1024 * INC, 1024, INC, WB + LW_WIN, 0, scr, lane)) continue;
        if (transpose_mat(r, pp->in[15] + (size_t)l * 262144, 256, 1024, WB + LW_AO, 0, scr, lane)) continue;
        if (transpose_mat(r, pp->in[18] + (size_t)l * 262144, 256, 1024, WB + LW_BO, 0, scr, lane)) continue;
        if (transpose_mat(r, pp->in[26] + (size_t)l * 262144, 256, 1024, WB + LW_DO, 0, scr, lane)) continue;
        if (transpose_mat(r, pp->in[21] + (size_t)l * 524288, 512, 1024, WB + LW_CO, 0, scr, lane)) continue;
        transpose_mat(r, pp->in[27] + (size_t)l * 1048576, 1024, 1024, WB + LW_O, 0, scr, lane);
    }
}

__device__ __forceinline__ void prologue(KP pp, unsigned char* lds_g, int tid, int lane, int wave, int vcu, int G) {
    LAS unsigned char* lds = (LAS unsigned char*)lds_g;
    convert_weights(pp, lds_g, 0, vcu * NWAVES + wave, G * NWAVES, lane, wave);
    __syncthreads();
    LAS float* sc = (LAS float*)lds;
    LAS float* part = (LAS float*)(lds + 32768);
    for (int i = tid; i < 5 * 1024; i += NTHR) { const int s = i >> 10, k = i & 1023; const float v = (s < 4) ? pp->in[1][s * 1024 + k] : pp->in[3][k]; sc[i] = fsilu(v); }
    __syncthreads();
    float* MOD = (float*)(pp->ws + WS_MOD);
    for (int it = vcu; it < 2 * 72; it += G) {
        const int l = it / 72, nb = it % 72; const int n = nb * 128 + 2 * lane;
        const float* wa = pp->in[4] + (size_t)l * 1024 * MODW + n;
        typedef float f32x2 __attribute__((ext_vector_type(2)));
        f32x2 a0 = {0.f, 0.f}, a1 = a0, a2 = a0, a3 = a0, a4 = a0;
#pragma unroll 8
        for (int kk = 0; kk < 128; ++kk) { const int k = wave * 128 + kk; const f32x2 w = *(const f32x2*)(wa + (size_t)k * MODW);
            a0 += w * sc[k]; a1 += w * sc[1024 + k]; a2 += w * sc[2048 + k]; a3 += w * sc[3072 + k]; a4 += w * sc[4096 + k]; }
        LAS f32x2* part2 = (LAS f32x2*)part;
        part2[(wave * 5 + 0) * 64 + lane] = a0; part2[(wave * 5 + 1) * 64 + lane] = a1; part2[(wave * 5 + 2) * 64 + lane] = a2; part2[(wave * 5 + 3) * 64 + lane] = a3; part2[(wave * 5 + 4) * 64 + lane] = a4;
        __syncthreads();
        if (tid < 320) { const int s = tid >> 6, cl = tid & 63; f32x2 v = *(const f32x2*)(pp->in[5] + l * MODW + nb * 128 + 2 * cl);
#pragma unroll
            for (int w = 0; w < 8; ++w) v += part2[(w * 5 + s) * 64 + cl];
            *(f32x2*)(MOD + ((size_t)l * 5 + s) * MODW + nb * 128 + 2 * cl) = v; }
        __syncthreads();
    }
    if (blockIdx.x == 0) {
        float* rc = (float*)(pp->ws + WS_ROPE); float* rs = rc + 1024;
        for (int i = tid; i < 1024; i += NTHR) { const int pos = i >> 4, f = i & 15;
            const float inv = exp2f(-(float)f * (13.287712379549449f / 16.0f));
            const float a = (float)pos * inv;
            const float kq = rintf(a * 0.15915494309189535f);
            float rr = fmaf(-kq, 6.2831854820251465f, a); rr = fmaf(-kq, -1.7484556000744883e-7f, rr);
            rc[i] = __cosf(rr); rs[i] = __sinf(rr); }
    }
    if (blockIdx.x == 1 && wave == 0) {
        float* LAM = (float*)(pp->ws + WS_LAM);
        for (int l = 0; l < 2; ++l) { const float* lp = pp->in[19] + l * 256;
            const float sa = wave_sum(lp[lane] * lp[64 + lane]), sb = wave_sum(lp[128 + lane] * lp[192 + lane]);
            int lo = l; float c08 = 0.8f, c06 = 0.6f, c1 = 1.0f; asm volatile("" : "+v"(lo), "+v"(c08), "+v"(c06), "+v"(c1)); const float lam_init = c08 - c06 * expf(-0.3f * (float)lo);
            if (lane == 0) { LAM[l * 2 + 0] = expf(sa) - expf(sb) + lam_init; asm volatile("" ::: "memory"); LAM[l * 2 + 1] = c1 - lam_init; } }
    }
}

__device__ __forceinline__ void norm_phase(KP pp, int l, int which, int lane, int gw, int NGW) {
    const int nrows = (l == 1 && which == 2) ? NX : MT;
    const bool first = (l == 0 && which == 0);
    const float* xs = first ? pp->in[0] : pp->out;
    const float* cs = (l == 0 && which <= 1) ? pp->in[2] : (const float*)(pp->ws + WS_CTX);
    const float* pgate = (const float*)(pp->ws + WS_MOD) + (size_t)((which == 0 ? l - 1 : l) * 5 + 4) * MODW + (which == 1 ? 2 : (which == 2 ? 5 : 8)) * 1024;
    const float pscale = (which == 2) ? 1.0f : 0.5f;
    const float* g = pp->in[6] + (l * 3 + which) * 1024; const float* MOD = (const float*)(pp->ws + WS_MOD) + (size_t)l * 5 * MODW;
    bf16* HN = (bf16*)(pp->ws + WS_HN);
    f32x4 gv[4];
#pragma unroll
    for (int j = 0; j < 4; ++j) gv[j] = *(const f32x4*)(g + 4 * lane + 256 * j);
    for (int blk = gw; blk * 8 < NX; blk += NGW) {
        const int r0 = blk * 8; const int set = r0 >> 12;
        const float* sh = MOD + (size_t)set * MODW + (3 * which) * 1024; const float* scl = sh + 1024;
        f32x4 gs[4], sv[4], cur[4], nxt[4];
#pragma unroll
        for (int j = 0; j < 4; ++j) { sv[j] = *(const f32x4*)(sh + 4 * lane + 256 * j); gs[j] = gv[j] * (*(const f32x4*)(scl + 4 * lane + 256 * j) + 1.0f); }
#pragma unroll
        for (int j = 0; j < 4; ++j) cur[j] = *(const f32x4*)(xs + (size_t)r0 * 1024 + 4 * lane + 256 * j);
#pragma unroll
        for (int i = 0; i < 8; ++i) {
            if (i < 7) {
#pragma unroll
                for (int j = 0; j < 4; ++j) nxt[j] = *(const f32x4*)(xs + (size_t)(r0 + i + 1) * 1024 + 4 * lane + 256 * j); }
            float s2 = 0.f;
#pragma unroll
            for (int j = 0; j < 4; ++j) s2 += (cur[j].x * cur[j].x + cur[j].y * cur[j].y) + (cur[j].z * cur[j].z + cur[j].w * cur[j].w);
            const float rstd = 1.0f / sqrtf(wave_sum(s2) * (1.0f / 1024.0f) + EPS);
#pragma unroll
            for (int j = 0; j < 4; ++j) { const f32x4 y = (cur[j] * rstd) * gs[j] + sv[j];
                u32x2 w; w.x = cvt_pk_bf16(y.x, y.y); w.y = cvt_pk_bf16(y.z, y.w);
                *(u32x2*)(HN + (size_t)(r0 + i) * 1024 + 4 * lane + 256 * j) = w; }
#pragma unroll
            for (int j = 0; j < 4; ++j) cur[j] = nxt[j];
        }
    }
    for (int r = NX + (NGW - 1 - gw); r < nrows; r += NGW) {
        const int set = 4;
        const float* xr = cs + (size_t)(r - NX) * 1024;
        const float* sh = MOD + (size_t)set * MODW + (3 * which) * 1024; const float* scl = sh + 1024;
        f32x4 v[4]; float s2 = 0.f;
#pragma unroll
        for (int j = 0; j < 4; ++j) v[j] = *(const f32x4*)(xr + 4 * lane + 256 * j);
        if (!first) {
            const float* PT = (const float*)(pp->ws + WS_PART) + (size_t)(r - NX) * 1024; float* cw = (float*)(pp->ws + WS_CTX) + (size_t)(r - NX) * 1024;
#pragma unroll
            for (int j = 0; j < 4; ++j) { const int o = 4 * lane + 256 * j;
                f32x4 ps = (*(const f32x4*)(PT + o) + *(const f32x4*)(PT + 1048576 + o)) + (*(const f32x4*)(PT + 2097152 + o) + *(const f32x4*)(PT + 3145728 + o));
                ps = ps + ((*(const f32x4*)(PT + 4194304 + o) + *(const f32x4*)(PT + 5242880 + o)) + (*(const f32x4*)(PT + 6291456 + o) + *(const f32x4*)(PT + 7340032 + o)));
                v[j] = v[j] + *(const f32x4*)(pgate + o) * pscale * ps; *(f32x4*)(cw + o) = v[j]; }
        }
#pragma unroll
        for (int j = 0; j < 4; ++j) s2 += (v[j].x * v[j].x + v[j].y * v[j].y) + (v[j].z * v[j].z + v[j].w * v[j].w);
        const float rstd = 1.0f / sqrtf(wave_sum(s2) * (1.0f / 1024.0f) + EPS);
#pragma unroll
        for (int j = 0; j < 4; ++j) { const f32x4 s = *(const f32x4*)(sh + 4 * lane + 256 * j), cc = *(const f32x4*)(scl + 4 * lane + 256 * j);
            const f32x4 y = (v[j] * rstd) * gv[j] * (cc + 1.0f) + s;
            u32x2 w; w.x = cvt_pk_bf16(y.x, y.y); w.y = cvt_pk_bf16(y.z, y.w);
            *(u32x2*)(HN + (size_t)r * 1024 + 4 * lane + 256 * j) = w; }
    }
}
__device__ __forceinline__ void final_norm(KP pp, int lane, int gw, int NGW) {
    const float* g = pp->in[28];
    f32x4 gg[4];
#pragma unroll
    for (int j = 0; j < 4; ++j) gg[j] = *(const f32x4*)(g + 4 * lane + 256 * j);
    for (int blk = gw; blk * 8 < NX; blk += NGW) { float* x0 = pp->out + (size_t)blk * 8 * 1024;
        f32x4 cur[4], nxt[4];
#pragma unroll
        for (int j = 0; j < 4; ++j) cur[j] = *(const f32x4*)(x0 + 4 * lane + 256 * j);
#pragma unroll
        for (int i = 0; i < 8; ++i) {
            if (i < 7) {
#pragma unroll
                for (int j = 0; j < 4; ++j) nxt[j] = *(const f32x4*)(x0 + (size_t)(i + 1) * 1024 + 4 * lane + 256 * j); }
            float s2 = 0.f;
#pragma unroll
            for (int j = 0; j < 4; ++j) s2 += (cur[j].x * cur[j].x + cur[j].y * cur[j].y) + (cur[j].z * cur[j].z + cur[j].w * cur[j].w);
            const float rstd = 1.0f / sqrtf(wave_sum(s2) * (1.0f / 1024.0f) + EPS);
#pragma unroll
            for (int j = 0; j < 4; ++j) *(f32x4*)(x0 + (size_t)i * 1024 + 4 * lane + 256 * j) = (cur[j] * rstd) * gg[j];
#pragma unroll
            for (int j = 0; j < 4; ++j) cur[j] = nxt[j];
        }
    }
}

__device__ __forceinline__ void unpack8(const u32x4 w, float* f) { f[0] = bf_lo(w.x); f[1] = bf_hi(w.x); f[2] = bf_lo(w.y); f[3] = bf_hi(w.y); f[4] = bf_lo(w.z); f[5] = bf_hi(w.z); f[6] = bf_lo(w.w); f[7] = bf_hi(w.w); }
__device__ __forceinline__ u32x4 pack8(const float* f) { u32x4 w; w.x = cvt_pk_bf16(f[0], f[1]); w.y = cvt_pk_bf16(f[2], f[3]); w.z = cvt_pk_bf16(f[4], f[5]); w.w = cvt_pk_bf16(f[6], f[7]); return w; }
__device__ __forceinline__ void batch_bounds(int r, int& b0, int& b1) { if (r < NX) { b0 = r & ~(SEQ - 1); b1 = b0 + SEQ; } else { b0 = NX + ((r - NX) & ~(CTXL - 1)); b1 = b0 + CTXL; } }

__device__ __forceinline__ void branch_a(KP pp, int l, int nrows, int gtid, int ngt) {
    bf16* PX = (bf16*)(pp->ws + WS_PX); const float* cw = pp->in[14] + l * 768;
    for (int it = gtid; it < nrows * 32; it += ngt) {
        const int r = it >> 5, c0 = (it & 31) * 8; int b0, b1; batch_bounds(r, b0, b1);
        float acc[8];
#pragma unroll
        for (int i = 0; i < 8; ++i) acc[i] = 0.f;
#pragma unroll
        for (int k = 0; k < 3; ++k) { const int rr = r + k - 1;
            if (rr >= b0 && rr < b1) { float cg[8], xi[8]; unpack8(*(const u32x4*)(PX + (size_t)rr * PXW + 256 + c0), cg); unpack8(*(const u32x4*)(PX + (size_t)rr * PXW + 512 + c0), xi);
                const f32x4 w0 = *(const f32x4*)(cw + k * 256 + c0), w1 = *(const f32x4*)(cw + k * 256 + c0 + 4);
                acc[0] += w0.x * cg[0] * xi[0]; acc[1] += w0.y * cg[1] * xi[1]; acc[2] += w0.z * cg[2] * xi[2]; acc[3] += w0.w * cg[3] * xi[3];
                acc[4] += w1.x * cg[4] * xi[4]; acc[5] += w1.y * cg[5] * xi[5]; acc[6] += w1.z * cg[6] * xi[6]; acc[7] += w1.w * cg[7] * xi[7]; } }
        float bg[8]; unpack8(*(const u32x4*)(PX + (size_t)r * PXW + c0), bg);
#pragma unroll
        for (int i = 0; i < 8; ++i) acc[i] *= bg[i];
        *(u32x4*)(PX + (size_t)r * PXW + c0) = pack8(acc);
    }
}

__device__ __forceinline__ void branch_b(KP pp, int l, int nrows, unsigned char* lds_g, int tid, int vcu, int G) {
    bf16* PX = (bf16*)(pp->ws + WS_PX); LAS unsigned short* vt = (LAS unsigned short*)lds_g;
    const int lane = tid & 63, wave = tid >> 6, quad = lane >> 4, l15 = lane & 15;
    const int nunits = (nrows / 128) * 4;
    for (int ut = G - 1 - vcu; ut < nunits; ut += G) {
        const int ch = ut >> 2, g = ut & 3; const int q = tid >> 2, part = tid & 3;
        const bf16* vr = PX + (size_t)(ch * 128 + q) * PXW + 1024;
        float s1 = 0.f, s2 = 0.f;
#pragma unroll
        for (int j = 0; j < 8; ++j) { float f[8]; unpack8(*(const u32x4*)(vr + part * 64 + j * 8), f);
#pragma unroll
            for (int i = 0; i < 8; ++i) { s1 += f[i]; s2 += f[i] * f[i]; } }
        s1 += __shfl_xor(s1, 1); s1 += __shfl_xor(s1, 2); s2 += __shfl_xor(s2, 1); s2 += __shfl_xor(s2, 2);
        const float mean = s1 * (1.0f / 256.0f); const float var = fmaxf(s2 * (1.0f / 256.0f) - mean * mean, 0.f); const float rstd = 1.0f / sqrtf(var + EPS);
#pragma unroll
        for (int j = 0; j < 2; ++j) { float f[8]; unpack8(*(const u32x4*)(vr + g * 64 + part * 16 + j * 8), f);
#pragma unroll
            for (int i = 0; i < 8; i += 2) { const unsigned w = cvt_pk_bf16((f[i] - mean) * rstd, (f[i + 1] - mean) * rstd);
                vt[(part * 16 + j * 8 + i) * 136 + q] = (unsigned short)(w & 0xffffu); vt[(part * 16 + j * 8 + i + 1) * 136 + q] = (unsigned short)(w >> 16); } }
        __syncthreads();
        f32x4 acc[4];
#pragma unroll
        for (int nt = 0; nt < 4; ++nt) acc[nt] = (f32x4){0.f, 0.f, 0.f, 0.f};
        const float* wrow = pp->in[16] + ((size_t)(l * 4 + g) * 128 + 16 * wave + l15) * 128 + 8 * quad;
#pragma unroll
        for (int ks = 0; ks < 4; ++ks) {
            const f32x4 w0 = *(const f32x4*)(wrow + 32 * ks), w1 = *(const f32x4*)(wrow + 32 * ks + 4);
            u32x4 aw; aw.x = cvt_pk_bf16(w0.x, w0.y); aw.y = cvt_pk_bf16(w0.z, w0.w); aw.z = cvt_pk_bf16(w1.x, w1.y); aw.w = cvt_pk_bf16(w1.z, w1.w);
            const pg8::bf16x8 a = __builtin_bit_cast(pg8::bf16x8, aw);
#pragma unroll
            for (int nt = 0; nt < 4; ++nt) { const pg8::bf16x8 b = *(const LAS pg8::bf16x8*)(vt + (16 * nt + l15) * 136 + 32 * ks + 8 * quad);
                acc[nt] = __builtin_amdgcn_mfma_f32_16x16x32_bf16(a, b, acc[nt], 0, 0, 0); }
        }
#pragma unroll
        for (int i = 0; i < 4; ++i) { const int p = 16 * wave + quad * 4 + i; const float bias = pp->in[17][(l * 4 + g) * 128 + p];
            bf16* up = PX + (size_t)(ch * 128 + p) * PXW + 768 + g * 64 + l15;
#pragma unroll
            for (int nt = 0; nt < 4; ++nt) { const float uv = __uint_as_float((unsigned)up[16 * nt] << 16); up[16 * nt] = (bf16)(cvt_pk_bf16(uv * (acc[nt][i] + bias), 0.f) & 0xffffu); } }
        __syncthreads();
    }
}

__device__ __forceinline__ void branch_d(KP pp, int l, int nrows, unsigned char* lds_g, int tid, int lane, int wave, int vcu, int G) {
    const bf16* PX = (const bf16*)(pp->ws + WS_PX); bf16* AD = (bf16*)(pp->ws + WS_ACTD);
    LAS float* hs = (LAS float*)lds_g;
    LAS float* cv = (LAS float*)(lds_g + 65536);
    const float* dw = pp->in[22] + l * 31 * 256; const float* db = pp->in[23] + l * 256; const float* lg = pp->in[24] + l * 256; const float* lb = pp->in[25] + l * 256;
    const int nunits = nrows / 32;
    for (int ut = G - 1 - vcu; ut < nunits; ut += G) {
        const int R0 = ut * 32; int b0, b1; batch_bounds(R0, b0, b1);
        for (int it = tid; it < 62 * 32; it += NTHR) { const int rr = it >> 5, c0 = (it & 31) * 8; const int r = R0 - 15 + rr;
            float h[8];
            if (r >= b0 && r < b1) { float z0[8], z1[8]; unpack8(*(const u32x4*)(PX + (size_t)r * PXW + D_OFF + c0), z0); unpack8(*(const u32x4*)(PX + (size_t)r * PXW + D_OFF + 256 + c0), z1);
#pragma unroll
                for (int i = 0; i < 8; ++i) h[i] = z0[i] * fsigmoid(z1[i]); }
            else {
#pragma unroll
                for (int i = 0; i < 8; ++i) h[i] = 0.f; }
            *(LAS f32x4*)(hs + rr * 256 + c0) = (f32x4){h[0], h[1], h[2], h[3]}; *(LAS f32x4*)(hs + rr * 256 + c0 + 4) = (f32x4){h[4], h[5], h[6], h[7]}; }
        __syncthreads();
        { const int c = tid & 255, half = tid >> 8; const float bias = db[c];
            float o[16];
#pragma unroll
            for (int i = 0; i < 16; ++i) o[i] = bias;
#pragma unroll
            for (int k = 0; k < 31; ++k) { const float w = dw[k * 256 + c];
#pragma unroll
                for (int i = 0; i < 16; ++i) o[i] += w * hs[(half * 16 + i + k) * 256 + c]; }
#pragma unroll
            for (int i = 0; i < 16; ++i) cv[(half * 16 + i) * 256 + c] = o[i]; }
        __syncthreads();
#pragma unroll
        for (int i = 0; i < 4; ++i) { const int rr = wave * 4 + i; const f32x4 v = *(const LAS f32x4*)(cv + rr * 256 + 4 * lane);
            const float mean = wave_sum((v.x + v.y) + (v.z + v.w)) * (1.0f / 256.0f); const f32x4 d = v - mean;
            const float var = wave_sum((d.x * d.x + d.y * d.y) + (d.z * d.z + d.w * d.w)) * (1.0f / 256.0f); const float rstd = 1.0f / sqrtf(var + EPS);
            const f32x4 gg = *(const f32x4*)(lg + 4 * lane), bb = *(const f32x4*)(lb + 4 * lane); const f32x4 y = d * rstd * gg + bb;
            u32x2 w; w.x = cvt_pk_bf16(fsilu(y.x), fsilu(y.y)); w.y = cvt_pk_bf16(fsilu(y.z), fsilu(y.w));
            *(u32x2*)(AD + (size_t)(R0 + rr) * 256 + 4 * lane) = w; }
        __syncthreads();
    }
}

__device__ __forceinline__ void act_c(KP pp, int l, int r0, int h, int tid) {
    const bf16* OB = (const bf16*)(pp->ws + WS_OB); bf16* PX = (bf16*)(pp->ws + WS_PX); const float* LAM = (const float*)(pp->ws + WS_LAM) + l * 2;
    const float lam = LAM[0], oml = LAM[1]; const float* sg = pp->in[20] + l * 128;
    const int sub = tid & 15; f32x4 g0 = *(const f32x4*)(sg + sub * 8), g1 = *(const f32x4*)(sg + sub * 8 + 4);
#pragma unroll
    for (int it = 0; it < 8; ++it) { const int r = r0 + it * 32 + (tid >> 4);
        float a[8], b[8], o[8]; unpack8(*(const u32x4*)(OB + (size_t)r * 1024 + h * 256 + sub * 8), a); unpack8(*(const u32x4*)(OB + (size_t)r * 1024 + h * 256 + 128 + sub * 8), b);
        float s2 = 0.f;
#pragma unroll
        for (int i = 0; i < 8; ++i) { o[i] = a[i] - lam * b[i]; s2 += o[i] * o[i]; }
        s2 += __shfl_xor(s2, 1); s2 += __shfl_xor(s2, 2); s2 += __shfl_xor(s2, 4); s2 += __shfl_xor(s2, 8);
        const float rs = oml / sqrtf(s2 * (1.0f / 128.0f) + EPS);
        o[0] *= rs * g0.x; o[1] *= rs * g0.y; o[2] *= rs * g0.z; o[3] *= rs * g0.w; o[4] *= rs * g1.x; o[5] *= rs * g1.y; o[6] *= rs * g1.z; o[7] *= rs * g1.w;
        *(u32x4*)(PX + (size_t)r * PXW + Q_OFF + h * 128 + sub * 8) = pack8(o); }
}

__device__ __forceinline__ void attn_mix_phase(KP pp, int l, unsigned char* lds_g, int tid, int lane, int wave, int vcu, int G) {
    using abf = attn_body::bf16;
    const abf* PX = (const abf*)(pp->ws + WS_PX); abf* OB = (abf*)(pp->ws + WS_OB);
    const int njobs = 256 + ((l == 0) ? 16 : 0);
    for (int j = vcu; j < njobs; j += G) {
        int b, h, r0, krow0, ntm, krow1, NT;
        if (j < 256) { const int bh = j >> 4, qb = j & 15; b = bh >> 2; h = bh & 3; r0 = b * SEQ + qb * 256; krow0 = b * SEQ; ntm = 64; krow1 = NX + b * CTXL; NT = 68; }
        else { const int w = j - 256; b = w >> 2; h = w & 3; r0 = NX + b * CTXL; krow0 = r0; ntm = 4; krow1 = r0; NT = 4; }
#pragma unroll 1
        for (int me_ = 0; me_ < 4 * MK_REP_ATTN; ++me_) { const int me = me_ & 3; const int m = me >> 1, e = me & 1;
            attn_body::attn_unit<8>(PX + (size_t)r0 * PXW + Q_OFF + h * 128 + m * 64, PX + K_OFF + h * 128 + m * 64, PX + V_OFF + h * 128 + e * 64,
                                    OB + (size_t)r0 * 1024 + h * 256 + m * 128 + e * 64, krow0, ntm, krow1, NT, (char*)lds_g); }
        __threadfence(); __syncthreads(); __builtin_amdgcn_fence(__ATOMIC_ACQUIRE, "agent");
        act_c(pp, l, r0, h, tid);
        __syncthreads();
    }
    const int nrows = (l == 0) ? MT : NX;
    branch_a(pp, l, nrows, vcu * NTHR + tid, G * NTHR);
    branch_b(pp, l, nrows, lds_g, tid, vcu, G);
    branch_d(pp, l, nrows, lds_g, tid, lane, wave, vcu, G);
}

__global__ void __launch_bounds__(NTHR, 2) mega_fwd(Params p) {
    extern __shared__ __attribute__((aligned(16))) unsigned char lds[];
    cg::grid_group grid = cg::this_grid();
    KP pk = (KP)__builtin_amdgcn_kernarg_segment_ptr();
    const int ph_lo = pk->ph_lo, ph_hi = pk->ph_hi;
    volatile LAS unsigned* bst = (volatile LAS unsigned*)((LAS unsigned char*)lds + 131072 + 64);
    if (threadIdx.x < 2) bst[threadIdx.x] = 0u;
    __syncthreads();
    XcdBarrier xbar = xcd_barrier_post((unsigned*)(pk->ws + WS_BAR), bst);
    for (int pi = ph_lo; pi < ph_hi; ++pi) {
        const int ph = (MK_REP_PH >= 0 && pi > MK_REP_PH) ? pi - 1 : pi;
        KP pp = pk; asm volatile("" : "+s"(pp));
        const int tid = tid_now(), lane = tid & 63, wave = __builtin_amdgcn_readfirstlane(tid >> 6);
        const int G = gridDim.x; int bx = blockIdx.x; asm volatile("" : "+s"(bx)); const int vcu = (G % 8 == 0) ? (bx % 8) * (G / 8) + bx / 8 : bx;
        const int gw = vcu * NWAVES + wave, NGW = G * NWAVES;
        pg8::LdsPtr ldsp = (pg8::LdsPtr)lds;
        if (ph == 0) prologue(pp, lds, tid, lane, wave, vcu, G);
        else if (ph == 23) final_norm(pp, lane, gw, NGW);
        else {
            const int l = (ph - 1) / 11, s = (ph - 1) % 11;
            bf16* HN = (bf16*)(pp->ws + WS_HN); bf16* PX = (bf16*)(pp->ws + WS_PX); bf16* MG = (bf16*)(pp->ws + WS_OB);
            const bf16* WB = (const bf16*)(pp->ws + WS_W) + (size_t)l * LW_TOTAL;
            if (s == 0 || s == 3 || s == 8) norm_phase(pp, l, s == 0 ? 0 : (s == 3 ? 1 : 2), lane, gw, NGW);
            else if (s == 1 || s == 9) {
                const int Mrows = (l == 1 && s == 9) ? NX : MT;
                pg8::Gemm g{HN, WB + (s == 1 ? LW_UP1 : LW_UP2), 1024, 1024, 1024}; pg8::StaticOrder S; S.init(Mrows, 5632, G, bx);
                pg8::EpiSwiGLU E{PX};
                pg8::gemm_phase<pg8::EpiSwiGLU, pg8::StaticOrder, true, true>(ldsp, g, S, E);
            } else if (s == 2 || s == 7 || s == 10) {
                const bool first = (l == 0 && s == 2); const bool ctxrows = !(l == 1 && s != 2);
                float* CTX = (float*)(pp->ws + WS_CTX); const float* MOD = (const float*)(pp->ws + WS_MOD) + (size_t)l * 5 * MODW;
                const bf16* A = (s == 7) ? MG : PX; const int lda = (s == 7) ? 1024 : FF; const int K = lda;
                const bf16* W = WB + (s == 2 ? LW_DN1 : (s == 7 ? LW_O : LW_DN2));
                { pg8::Gemm g{A, W, lda, K, K}; pg8::StaticOrder S; S.init(NX, 1024, G, bx);
                  pg8::EpiRes E{first ? pp->in[0] : pp->out, CTX, pp->out, CTX, MOD + (s == 2 ? 2 : (s == 7 ? 5 : 8)) * 1024, (s == 7) ? 1.0f : 0.5f};
                  pg8::gemm_phase<pg8::EpiRes, pg8::StaticOrder, true, true>(ldsp, g, S, E); }
                if (ctxrows && (bx & 1) == 1) {
                    KP pq = pk; asm volatile("" : "+s"(pq));
                    const int j = bx >> 1, ut = j >> 3, sp = j & 7;
                    pg8::OneUnit S1{pg8::Unit{64 + (ut >> 2), ut & 3}};
                    const bf16* WB2 = (const bf16*)(pq->ws + WS_W) + (size_t)l * LW_TOTAL; float* PT = (float*)(pq->ws + WS_PART) + (size_t)sp * 1048576;
                    const bf16* A2; const bf16* W2; int ld2, kc;
                    if (s == 7) { const int kh = (sp & 1) * 512;
                        A2 = (const bf16*)(pq->ws + WS_MGP) + (size_t)(sp >> 1) * 1048576 - (size_t)NX * 1024 + kh; W2 = WB2 + LW_O + kh; ld2 = 1024; kc = 512;
                    } else { const int k0 = (sp < 6) ? sp * 384 : 2304 + (sp - 6) * 256;
                        A2 = (const bf16*)(pq->ws + WS_PX) + k0; W2 = WB2 + (s == 2 ? LW_DN1 : LW_DN2) + k0; ld2 = FF; kc = (sp < 6) ? 384 : 256; }
                    pg8::Gemm g{A2, W2, ld2, ld2, kc}; pg8::EpiPart E{PT};
                    pg8::gemm_phase<pg8::EpiPart, pg8::OneUnit, true, true>(ldsp, g, S1, E);
                }
            } else if (s == 4) {
                pg8::Gemm g{HN, WB + LW_WIN, 1024, 1024, 1024}; pg8::StaticOrder S; S.init(MT, PXW, G, bx);
                pg8::EpiWin E{PX, (const float*)(pp->ws + WS_ROPE), (const float*)(pp->ws + WS_ROPE) + 1024, C2};
                pg8::gemm_phase<pg8::EpiWin, pg8::StaticOrder, true, true>(ldsp, g, S, E);
            } else if (s == 5) attn_mix_phase(pp, l, lds, tid, lane, wave, vcu, G);
            else if (s == 6) {
                const int nctx = (l == 0 && (bx & 3) == 1) ? 1 : 0;
                pg8::StaticOrder S; S.init(NX, 1024, G, bx); pg8::Unit u;
                for (int i = 0; i < 1 + nctx; ++i) {
                    int br_lo = 0, br_hi = 4;
                    if (i == 0) { if (!S.next(0, u)) continue; }
                    else { const int j = bx >> 2, ut = j >> 2; u.pm = 64 + (ut >> 2); u.pn = ut & 3; br_lo = j & 3; br_hi = br_lo + 1; }
#pragma unroll 1
                    for (int br = br_lo; br < br_hi; ++br) {
                        if (!((MK_BRMASK >> br) & 1)) continue;
                        KP pq = pk; asm volatile("" : "+s"(pq));
                        bf16* GSw = (bf16*)(pq->ws + WS_GS) + (size_t)bx * 65536; const bf16* HN2 = (const bf16*)(pq->ws + WS_HN);
                        const bf16* WB2 = (const bf16*)(pq->ws + WS_W) + (size_t)l * LW_TOTAL;
                        pg8::OneUnit S1{u};
                        { pg8::Gemm g{HN2, WB2 + LW_WIN + (size_t)(G_OFF + br * 1024) * 1024, 1024, 1024, 1024}; pg8::EpiGate E{GSw};
                          pg8::gemm_phase<pg8::EpiGate, pg8::OneUnit, true, true>(ldsp, g, S1, E); }
                        const bf16* PX2 = (const bf16*)(pq->ws + WS_PX);
                        const bf16* A = (br == 0) ? PX2 + A_OFF : (br == 1) ? PX2 + B_OFF : (br == 2) ? PX2 + Q_OFF : (const bf16*)(pq->ws + WS_ACTD);
                        const int lda = (br == 3) ? 256 : PXW; const int K = (br == 2) ? 512 : 256;
                        const bf16* W = WB2 + ((br == 0) ? LW_AO : (br == 1) ? LW_BO : (br == 2) ? LW_CO : LW_DO);
                        bf16* MGd = (i == 0) ? (bf16*)(pq->ws + WS_OB) : (bf16*)(pq->ws + WS_MGP) + (size_t)br * 1048576 - (size_t)NX * 1024;
                        { pg8::Gemm g{A, W, lda, K, K}; pg8::EpiBranch E{GSw, MGd, (i == 0) ? ((MK_BRMASK & ((1 << br) - 1)) == 0) : 1};
                          pg8::gemm_phase<pg8::EpiBranch, pg8::OneUnit, true, true>(ldsp, g, S1, E); }
                    }
                }
                if (l == 0 && (bx & 3) != 1) {
                    KP pq = pk; asm volatile("" : "+s"(pq));
                    convert_weights(pq, lds, 1, (bx - ((bx + 2) >> 2)) * NWAVES + wave, (G - G / 4) * NWAVES, lane, wave);
                }
            }
        }
        if (pi + 1 < ph_hi) {
            if (ph_hi > 4096) grid.sync();
            xcd_barrier(xbar);
        }
    }
}


extern "C" void kernel_launch(void* const* d_in, const int* in_sizes, int n_in, void* d_out, int out_size, void* d_ws, size_t ws_size, hipStream_t stream) {
    static int grid = 0;
    if (grid == 0) {
        if (n_in != 29 || out_size != NX * 1024 || ws_size < WS_END) { fprintf(stderr, "kernel_launch: unexpected shapes / workspace (n_in %d out %d ws %zu)\n", n_in, out_size, ws_size); grid = -1; return; }
        int dev = 0, cus = 0, per_cu = 0;
        if (hipGetDevice(&dev) != hipSuccess || hipDeviceGetAttribute(&cus, hipDeviceAttributeMultiprocessorCount, dev) != hipSuccess) { grid = -1; return; }
        if (hipFuncSetAttribute((const void*)mega_fwd, hipFuncAttributeMaxDynamicSharedMemorySize, LDS_BYTES) != hipSuccess) { fprintf(stderr, "kernel_launch: hipFuncSetAttribute failed\n"); grid = -1; return; }
        if (hipOccupancyMaxActiveBlocksPerMultiprocessor(&per_cu, (const void*)mega_fwd, NTHR, LDS_BYTES) != hipSuccess || per_cu < 1) { fprintf(stderr, "kernel_launch: occupancy query says %d\n", per_cu); per_cu = 1; }
        (void)hipGetLastError();
        grid = cus;
    }
    if (grid < 0) return;
    if (hipMemsetAsync((char*)d_ws + WS_BAR, 0, 16384, stream) != hipSuccess) { fprintf(stderr, "kernel_launch: memset failed\n"); return; }
    Params p{};
    for (int i = 0; i < 29; ++i) p.in[i] = (const float*)d_in[i];
    p.out = (float*)d_out; p.ws = (unsigned char*)d_ws;
#if MK_PER_PHASE
    for (int ph = 0; ph < 24; ++ph) { if (ph >= MK_NPH && ph != 23) continue; p.ph_lo = ph; p.ph_hi = ph + 1; hipLaunchKernelGGL(mega_fwd, dim3(grid), dim3(NTHR), LDS_BYTES, stream, p); }
#else
    p.ph_lo = 0; p.ph_hi = 24 + ((MK_REP_PH >= 0) ? 1 : 0);
    void* args[] = {&p};
    hipError_t e = hipLaunchCooperativeKernel((const void*)mega_fwd, dim3(grid), dim3(NTHR), args, LDS_BYTES, stream);
    if (e != hipSuccess) fprintf(stderr, "cooperative launch failed: %s (grid %d)\n", hipGetErrorString(e), grid);
#endif
}
```

```cpp
#include <hip/hip_runtime.h>
#include <hip/hip_cooperative_groups.h>
#include <hip/hip_bf16.h>
#include <cstdio>
#include <cstdint>
#include <cmath>
namespace cg = cooperative_groups;
__device__ __forceinline__ int tid_now() { int t = threadIdx.x; asm volatile("" : "+v"(t)); return t; }
#ifndef MK_PER_PHASE
#define MK_PER_PHASE 0
#endif
#ifndef MK_NPH
#define MK_NPH 24
#endif
#ifndef MK_BRMASK
#define MK_BRMASK 15
#endif
#ifndef MK_REP_PH
#define MK_REP_PH -1
#endif
#ifndef MK_REP_ATTN
#define MK_REP_ATTN 1
#endif
namespace pg8 {
#define PG8_LAS __attribute__((address_space(3)))
typedef unsigned short bf16_t;
typedef short bf16x8 __attribute__((ext_vector_type(8)));
typedef float f32x4 __attribute__((ext_vector_type(4)));
typedef unsigned u32x4 __attribute__((ext_vector_type(4)));
typedef PG8_LAS unsigned char* LdsPtr;
constexpr int BM = 256, BK = 64, HALF = 128, HTB = HALF * BK * 2  , STAGE_BYTES = 8 * HTB, NXCD = 8, WGM = 8;

__host__ __device__ __forceinline__ int lds_byte(int r, int c) { const int st = (r >> 4) * 2 + (c >> 5), rr = r & 15, cc = c & 31, ob = rr * 64 + cc * 2; return st * 1024 + (ob ^ (((ob >> 9) & 1) << 5)); }
__host__ __device__ __forceinline__ void stage_rc(int b, int& R, int& C) { const int st = b / 1024, sb = b % 1024, swz = sb ^ (((sb >> 9) & 1) << 5); R = (st >> 1) * 16 + swz / 64; C = (st & 1) * 32 + (swz % 64) / 2; }
__host__ __device__ __forceinline__ int perm32(int rho) { const int n = rho >> 4, i = rho & 15; return 8 * (i >> 2) + 4 * n + (i & 3); }

struct Unit { int pm, pn; };
struct Gemm { const bf16_t* A; const bf16_t* Bt; int lda, ldb, K; };

struct StaticOrder {
    int nM, nN, nwg, G, c;
    __host__ __device__ void init(int M, int N, int G_, int c_) { nM = M / BM; nN = N / BM; nwg = nM * nN; G = G_; c = c_; }
    __host__ __device__ bool next(int i, Unit& u) const {
        const long L = (long)i * G + c; if (L >= nwg) return false;
        int wgid = (int)L; { const int q = nwg / NXCD, r = nwg % NXCD, xcd = wgid % NXCD, off = wgid / NXCD; wgid = (xcd < r ? xcd * (q + 1) : r * (q + 1) + (xcd - r) * q) + off; }
        const int nig = WGM * nN, gid = wgid / nig, fm = gid * WGM, gsz = (nM - fm) < WGM ? (nM - fm) : WGM;
        u.pm = fm + ((wgid % nig) % gsz); u.pn = (wgid % nig) / gsz; return true;
    }
    __device__ __forceinline__ void a_ready(const Unit&) const {}
    __device__ __forceinline__ void done(const Unit&) const {}
};


struct OneUnit {
    Unit u;
    __device__ __forceinline__ bool next(int i, Unit& o) const { if (i) return false; o = u; return true; }
    __device__ __forceinline__ void a_ready(const Unit&) const {}
    __device__ __forceinline__ void done(const Unit&) const {}
};

typedef float f32x2_cv __attribute__((ext_vector_type(2))); typedef __bf16 bf16x2_cv __attribute__((ext_vector_type(2)));
__device__ __forceinline__ unsigned cvt_pk_bf16(float lo, float hi) { f32x2_cv v = {lo, hi}; bf16x2_cv b = __builtin_convertvector(v, bf16x2_cv); return __builtin_bit_cast(unsigned, b); }
typedef unsigned u32x2 __attribute__((ext_vector_type(2)));
__device__ __forceinline__ float fsigmoid(float v) { return __builtin_amdgcn_rcpf(1.0f + __builtin_amdgcn_exp2f(-1.4426950408889634f * v)); }
__device__ __forceinline__ float fsilu(float v) { return v * fsigmoid(v); }
__device__ __forceinline__ float ftanh(float v) { return 2.0f * fsigmoid(2.0f * v) - 1.0f; }
__device__ __forceinline__ float fgelu_tanh(float v) { const float u = 0.7978845608028654f * (v + 0.044715f * v * v * v); return v * fsigmoid(2.0f * u); }
__device__ __forceinline__ float bf_lo(unsigned w) { return __uint_as_float(w << 16); }
__device__ __forceinline__ float bf_hi(unsigned w) { return __uint_as_float(w & 0xffff0000u); }

constexpr int ROWS_X = 16384, PXW = 3328, DFF = 2816, MODW = 9216;

struct EpiSwiGLU {
    static constexpr bool PERM = true, AFTER_DRAIN = false;
    bf16_t* H;
    __device__ __forceinline__ void operator()(const f32x4 (&acc)[2][2][4][2], const Unit& u, int wr, int wc, int fr, int fq) const {
        const int row0 = u.pm * BM + wr * 64 + fr, col0 = u.pn * HALF + wc * 32 + 8 * fq;
#pragma unroll
        for (int ai = 0; ai < 2; ++ai)
#pragma unroll
            for (int m = 0; m < 4; ++m) {
                bf16_t* rowp = H + (size_t)(row0 + ai * HALF + m * 16) * DFF + col0;
                const f32x4 a0 = acc[ai][0][m][0], a1 = acc[ai][0][m][1], b0 = acc[ai][1][m][0], b1 = acc[ai][1][m][1];
                u32x4 w;
                w.x = cvt_pk_bf16(fsilu(a0[0]) * b0[0], fsilu(a0[1]) * b0[1]); w.y = cvt_pk_bf16(fsilu(a0[2]) * b0[2], fsilu(a0[3]) * b0[3]);
                w.z = cvt_pk_bf16(fsilu(a1[0]) * b1[0], fsilu(a1[1]) * b1[1]); w.w = cvt_pk_bf16(fsilu(a1[2]) * b1[2], fsilu(a1[3]) * b1[3]);
                *(u32x4*)rowp = w;
            }
    }
};

struct EpiRes {
    static constexpr bool PERM = false, AFTER_DRAIN = false;
    const float* bx; const float* bc; float* ox; float* oc; const float* gate; float sc;
    __device__ __forceinline__ void operator()(const f32x4 (&acc)[2][2][4][2], const Unit& u, int wr, int wc, int fr, int fq) const {
        const bool isx = u.pm < 64; const int set = isx ? (u.pm >> 4) : 4;
        const size_t roff = (size_t)(isx ? u.pm : u.pm - 64) * BM * 1024;
        const float* base = (isx ? bx : bc) + roff; float* out = (isx ? ox : oc) + roff;
        const int col0 = u.pn * BM + wc * 32 + 4 * fq; const float* gp = gate + (size_t)set * MODW + col0;
        f32x4 gv[2][2];
#pragma unroll
        for (int bj = 0; bj < 2; ++bj)
#pragma unroll
            for (int n = 0; n < 2; ++n) gv[bj][n] = *(const f32x4*)(gp + bj * HALF + n * 16) * sc;
#pragma unroll
        for (int ai = 0; ai < 2; ++ai)
#pragma unroll
            for (int m = 0; m < 4; ++m) {
                const size_t off = (size_t)(ai * HALF + wr * 64 + m * 16 + fr) * 1024 + col0;
#pragma unroll
                for (int bj = 0; bj < 2; ++bj)
#pragma unroll
                    for (int n = 0; n < 2; ++n) {
                        const f32x4 b = *(const f32x4*)(base + off + bj * HALF + n * 16);
                        *(f32x4*)(out + off + bj * HALF + n * 16) = b + gv[bj][n] * acc[ai][bj][m][n];
                    }
            }
    }
};

__device__ __forceinline__ float lane32_partner(float x, bool hi) { auto rr = __builtin_amdgcn_permlane32_swap(__float_as_uint(x), __float_as_uint(x), false, false); return __uint_as_float(hi ? rr[0] : rr[1]); }
struct EpiWin {
    static constexpr bool PERM = true, AFTER_DRAIN = false;
    bf16_t* PX; const float* rcos; const float* rsin; float qscale;
    __device__ __forceinline__ void operator()(const f32x4 (&acc)[2][2][4][2], const Unit& u, int wr, int wc, int fr, int fq) const {
        const int pn = u.pn; const bool isx = u.pm < 64;
        const bool gel = (pn == 3 || pn == 4), isq = (pn == 5 || pn == 6), rope = (pn >= 5 && pn <= 8) && isx;
        const float sc = isq ? qscale : 1.0f; const bool hi = fq >= 2; const float sgn = hi ? 1.0f : -1.0f;
        const int col0 = pn * BM + wc * 32 + 8 * fq;
#pragma unroll
        for (int ai = 0; ai < 2; ++ai)
#pragma unroll
            for (int m = 0; m < 4; ++m) {
                const int row = u.pm * BM + ai * HALF + wr * 64 + m * 16 + fr;
                bf16_t* rowp = PX + (size_t)row * PXW + col0;
                f32x4 c0 = (f32x4){1.f, 1.f, 1.f, 1.f}, c1 = c0, s0 = (f32x4){0.f, 0.f, 0.f, 0.f}, s1 = s0;
                if (rope) { const int pos = (wc & 1) ? (m * 16 + fr) : ((4 * u.pm + 2 * ai + wr) & 63); const int fo = pos * 16 + 8 * (fq & 1);
                    c0 = *(const f32x4*)(rcos + fo); c1 = *(const f32x4*)(rcos + fo + 4); s0 = *(const f32x4*)(rsin + fo) * sgn; s1 = *(const f32x4*)(rsin + fo + 4) * sgn; }
#pragma unroll
                for (int bj = 0; bj < 2; ++bj) {
                    f32x4 v0 = acc[ai][bj][m][0], v1 = acc[ai][bj][m][1];
                    if (gel) {
#pragma unroll
                        for (int i = 0; i < 4; ++i) { v0[i] = fgelu_tanh(v0[i]); v1[i] = fgelu_tanh(v1[i]); }
                    }
                    if (rope) { f32x4 p0, p1;
#pragma unroll
                        for (int i = 0; i < 4; ++i) { p0[i] = lane32_partner(v0[i], hi); p1[i] = lane32_partner(v1[i], hi); }
                        v0 = v0 * c0 + p0 * s0; v1 = v1 * c1 + p1 * s1; }
                    v0 = v0 * sc; v1 = v1 * sc;
                    u32x4 w; w.x = cvt_pk_bf16(v0[0], v0[1]); w.y = cvt_pk_bf16(v0[2], v0[3]); w.z = cvt_pk_bf16(v1[0], v1[1]); w.w = cvt_pk_bf16(v1[2], v1[3]);
                    *(u32x4*)(rowp + bj * HALF) = w;
                }
            }
    }
};

struct EpiGate {
    static constexpr bool PERM = true, AFTER_DRAIN = false;
    bf16_t* GS;
    __device__ __forceinline__ void operator()(const f32x4 (&acc)[2][2][4][2], const Unit& u, int wr, int wc, int fr, int fq) const {
        const int tid = tid_now();
#pragma unroll
        for (int ai = 0; ai < 2; ++ai)
#pragma unroll
            for (int bj = 0; bj < 2; ++bj)
#pragma unroll
                for (int m = 0; m < 4; ++m) {
                    const f32x4 a0 = acc[ai][bj][m][0], a1 = acc[ai][bj][m][1];
                    u32x4 w; w.x = cvt_pk_bf16(fsigmoid(a0[0]), fsigmoid(a0[1])); w.y = cvt_pk_bf16(fsigmoid(a0[2]), fsigmoid(a0[3]));
                    w.z = cvt_pk_bf16(fsigmoid(a1[0]), fsigmoid(a1[1])); w.w = cvt_pk_bf16(fsigmoid(a1[2]), fsigmoid(a1[3]));
                    *(u32x4*)(GS + ((size_t)(((ai * 2 + bj) * 4 + m) * 512 + tid)) * 8) = w;
                }
    }
};

struct EpiBranch {
    static constexpr bool PERM = true, AFTER_DRAIN = false;
    const bf16_t* GS; bf16_t* MG; int first;
    __device__ __forceinline__ void operator()(const f32x4 (&acc)[2][2][4][2], const Unit& u, int wr, int wc, int fr, int fq) const {
        const int tid = tid_now();
        const int row0 = u.pm * BM + wr * 64 + fr, col0 = u.pn * BM + wc * 32 + 8 * fq;
#pragma unroll
        for (int ai = 0; ai < 2; ++ai)
#pragma unroll
            for (int bj = 0; bj < 2; ++bj)
#pragma unroll
                for (int m = 0; m < 4; ++m) {
                    const u32x4 g = *(const u32x4*)(GS + ((size_t)(((ai * 2 + bj) * 4 + m) * 512 + tid)) * 8);
                    bf16_t* mp = MG + (size_t)(row0 + ai * HALF + m * 16) * 1024 + col0 + bj * HALF;
                    const f32x4 a0 = acc[ai][bj][m][0], a1 = acc[ai][bj][m][1];
                    float v[8] = {bf_lo(g.x) * a0[0], bf_hi(g.x) * a0[1], bf_lo(g.y) * a0[2], bf_hi(g.y) * a0[3], bf_lo(g.z) * a1[0], bf_hi(g.z) * a1[1], bf_lo(g.w) * a1[2], bf_hi(g.w) * a1[3]};
                    if (!first) { const u32x4 o = *(const u32x4*)mp;
                        v[0] += bf_lo(o.x); v[1] += bf_hi(o.x); v[2] += bf_lo(o.y); v[3] += bf_hi(o.y); v[4] += bf_lo(o.z); v[5] += bf_hi(o.z); v[6] += bf_lo(o.w); v[7] += bf_hi(o.w); }
                    u32x4 w; w.x = cvt_pk_bf16(v[0], v[1]); w.y = cvt_pk_bf16(v[2], v[3]); w.z = cvt_pk_bf16(v[4], v[5]); w.w = cvt_pk_bf16(v[6], v[7]);
                    *(u32x4*)mp = w;
                }
    }
};


struct EpiPart {
    static constexpr bool PERM = false, AFTER_DRAIN = false;
    float* P;
    __device__ __forceinline__ void operator()(const f32x4 (&acc)[2][2][4][2], const Unit& u, int wr, int wc, int fr, int fq) const {
        const int col0 = u.pn * BM + wc * 32 + 4 * fq;
#pragma unroll
        for (int ai = 0; ai < 2; ++ai)
#pragma unroll
            for (int m = 0; m < 4; ++m) {
                float* rp = P + (size_t)((u.pm - 64) * BM + ai * HALF + wr * 64 + m * 16 + fr) * 1024 + col0;
#pragma unroll
                for (int bj = 0; bj < 2; ++bj)
#pragma unroll
                    for (int n = 0; n < 2; ++n) *(f32x4*)(rp + bj * HALF + n * 16) = acc[ai][bj][m][n];
            }
    }
};
template <class Epi, class Sched, bool ALIGN_EPI = false, bool SP2 = false>
__device__ __forceinline__ void gemm_phase(PG8_LAS unsigned char* lds, const Gemm g, const Sched& S, const Epi& E) {
    const int tid = tid_now(), wid = __builtin_amdgcn_readfirstlane(tid >> 6), lane = tid & 63, wr = wid >> 2, wc = wid & 3, fr = lane & 15, fq = lane >> 4;
    const int K = g.K, nt = K / BK;
    unsigned voffA[2], voffB[2];
#pragma unroll
    for (int i = 0; i < 2; ++i) { int R, C; stage_rc(tid * 16 + i * 8192, R, C); const int Rb = Epi::PERM ? ((R & ~31) + perm32(R & 31)) : R;
        voffA[i] = (unsigned)(R * g.lda + C) * 2u; voffB[i] = (unsigned)(Rb * g.ldb + C) * 2u; }
    const size_t kstep = (size_t)(BK * 2);
    const size_t hsA = (size_t)HALF * g.lda * 2, hsB = (size_t)HALF * g.ldb * 2;
    const size_t tsA = 2 * hsA, tsB = 2 * hsB;
    const unsigned ldsw = (unsigned)wid * 1024u;
    const int aoff = lds_byte(wr * 64 + fr, fq * 8), boff = lds_byte(wc * 32 + fr, fq * 8);
#define PG8_SA(b, h) (((b) * 2 + (h)) * HTB)
#define PG8_SB(b, h) ((4 + (b) * 2 + (h)) * HTB)
#define PG8_STAGE(bufoff, gbase, voff) do { _Pragma("unroll") for (int _i = 0; _i < 2; ++_i) \
        __builtin_amdgcn_global_load_lds((const unsigned*)((const char*)(gbase) + (voff)[_i]), (PG8_LAS unsigned*)(lds + (bufoff) + ldsw + _i * 8192), 16, 0, 0); } while (0)
#define PG8_LDA(dst, b, h) do { _Pragma("unroll") for (int m = 0; m < 4; ++m) _Pragma("unroll") for (int k = 0; k < 2; ++k) dst[m][k] = *(const PG8_LAS bf16x8*)(lds + PG8_SA(b, h) + aoff + m * 2048 + k * 1024); } while (0)
#define PG8_LDB(dst, b, h) do { _Pragma("unroll") for (int n = 0; n < 2; ++n) _Pragma("unroll") for (int k = 0; k < 2; ++k) dst[n][k] = *(const PG8_LAS bf16x8*)(lds + PG8_SB(b, h) + boff + n * 2048 + k * 1024); } while (0)
#define PG8_MMA(ai, bj, At, Bt) do { __builtin_amdgcn_s_setprio(1); _Pragma("unroll") for (int m = 0; m < 4; ++m) _Pragma("unroll") for (int n = 0; n < 2; ++n) _Pragma("unroll") for (int k = 0; k < 2; ++k) \
        acc[ai][bj][m][n] = __builtin_amdgcn_mfma_f32_16x16x32_bf16(Bt[n][k], At[m][k], acc[ai][bj][m][n], 0, 0, 0); __builtin_amdgcn_s_setprio(0); } while (0)
#define PG8_WAIT_V(n) asm volatile("s_waitcnt vmcnt(" #n ")" ::: "memory")
#define PG8_WAIT_L(n) asm volatile("s_waitcnt lgkmcnt(" #n ")" ::: "memory")
#define PG8_BAR __builtin_amdgcn_s_barrier()
#define PG8_SCHED __builtin_amdgcn_sched_barrier(0)
    Unit cur, nxt; int ui = 0;
    if (!S.next(0, cur)) return;
    f32x4 acc[2][2][4][2];
#pragma unroll
    for (int a = 0; a < 2; ++a)
#pragma unroll
        for (int b = 0; b < 2; ++b)
#pragma unroll
            for (int m = 0; m < 4; ++m)
#pragma unroll
                for (int n = 0; n < 2; ++n) acc[a][b][m][n] = (f32x4){0.f, 0.f, 0.f, 0.f};
    bf16x8 At[4][2], B0[2][2], B1[2][2];
    const char* cA = (const char*)g.A + (size_t)cur.pm * tsA; const char* cB = (const char*)g.Bt + (size_t)cur.pn * tsB;
    S.a_ready(cur);
    if constexpr (SP2) {
        PG8_STAGE(PG8_SB(0, 0), cB, voffB); PG8_STAGE(PG8_SB(0, 1), cB + hsB, voffB); PG8_STAGE(PG8_SA(0, 0), cA, voffA); PG8_STAGE(PG8_SA(0, 1), cA + hsA, voffA);
        if (wr == 1) PG8_BAR;
        PG8_WAIT_V(2); PG8_BAR;
        PG8_STAGE(PG8_SB(1, 0), cB + kstep, voffB); PG8_STAGE(PG8_SA(1, 0), cA + kstep, voffA); PG8_STAGE(PG8_SB(1, 1), cB + hsB + kstep, voffB);
        PG8_WAIT_V(6); PG8_BAR;
    } else {
        PG8_STAGE(PG8_SB(0, 0), cB, voffB); PG8_STAGE(PG8_SA(0, 0), cA, voffA); PG8_STAGE(PG8_SB(0, 1), cB + hsB, voffB); PG8_STAGE(PG8_SA(0, 1), cA + hsA, voffA);
        if (wr == 1) PG8_BAR;
        PG8_WAIT_V(4); PG8_BAR;
        PG8_STAGE(PG8_SB(1, 0), cB + kstep, voffB); PG8_STAGE(PG8_SA(1, 0), cA + kstep, voffA); PG8_STAGE(PG8_SB(1, 1), cB + hsB + kstep, voffB);
        PG8_WAIT_V(6); PG8_BAR;
    }
    for (;;) {
        const bool has_next = S.next(ui + 1, nxt);
        const char* nA = has_next ? (const char*)g.A + (size_t)nxt.pm * tsA : cA; const char* nB = has_next ? (const char*)g.Bt + (size_t)nxt.pn * tsB : cB;
        for (int t = 0; t < nt; t += 2) {
            const bool last = (t == nt - 2);
            const char* a1 = cA + (size_t)(t + 1) * kstep;
            const char* a2 = last ? nA : cA + (size_t)(t + 2) * kstep; const char* b2 = last ? nB : cB + (size_t)(t + 2) * kstep;
            const char* a3 = a2 + kstep; const char* b3 = b2 + kstep;
            if (last && has_next) S.a_ready(nxt);
            if constexpr (SP2) {
            PG8_LDB(B0, 0, 0); PG8_LDB(B1, 0, 1); PG8_SCHED; PG8_LDA(At, 0, 0); PG8_STAGE(PG8_SA(1, 1), a1 + hsA, voffA);
            PG8_WAIT_V(8); PG8_WAIT_L(0); PG8_BAR; PG8_MMA(0, 0, At, B0); PG8_MMA(0, 1, At, B1); PG8_BAR; PG8_SCHED;
            PG8_LDA(At, 0, 1); PG8_STAGE(PG8_SB(0, 0), b2, voffB); PG8_STAGE(PG8_SB(0, 1), b2 + hsB, voffB); PG8_STAGE(PG8_SA(0, 0), a2, voffA);
            PG8_WAIT_V(8); PG8_WAIT_L(0); PG8_BAR; PG8_MMA(1, 0, At, B0); PG8_MMA(1, 1, At, B1); PG8_BAR; PG8_SCHED;
            PG8_LDB(B0, 1, 0); PG8_LDB(B1, 1, 1); PG8_SCHED; PG8_LDA(At, 1, 0); PG8_STAGE(PG8_SA(0, 1), a2 + hsA, voffA);
            PG8_WAIT_V(8); PG8_WAIT_L(0); PG8_BAR; PG8_MMA(0, 0, At, B0); PG8_MMA(0, 1, At, B1); PG8_BAR; PG8_SCHED;
            PG8_LDA(At, 1, 1); PG8_STAGE(PG8_SB(1, 0), b3, voffB); PG8_STAGE(PG8_SB(1, 1), b3 + hsB, voffB); PG8_STAGE(PG8_SA(1, 0), a3, voffA);
            PG8_WAIT_V(8); PG8_WAIT_L(0); PG8_BAR; PG8_MMA(1, 0, At, B0); PG8_MMA(1, 1, At, B1); PG8_BAR; PG8_SCHED;
            } else {
            PG8_LDB(B0, 0, 0); PG8_SCHED; PG8_LDA(At, 0, 0); PG8_STAGE(PG8_SA(1, 1), a1 + hsA, voffA);
            PG8_WAIT_L(8); PG8_BAR; PG8_WAIT_L(0); PG8_MMA(0, 0, At, B0); PG8_BAR; PG8_SCHED;
            PG8_LDB(B1, 0, 1); PG8_STAGE(PG8_SB(0, 0), b2, voffB);
            PG8_BAR; PG8_WAIT_L(0); PG8_MMA(0, 1, At, B1); PG8_BAR;
            PG8_LDA(At, 0, 1); PG8_STAGE(PG8_SA(0, 0), a2, voffA);
            PG8_BAR; PG8_WAIT_L(0); PG8_MMA(1, 0, At, B0); PG8_BAR; PG8_SCHED;
            PG8_STAGE(PG8_SB(0, 1), b2 + hsB, voffB);
            PG8_WAIT_V(6); PG8_BAR; PG8_MMA(1, 1, At, B1); PG8_BAR;
            PG8_LDB(B0, 1, 0); PG8_SCHED; PG8_LDA(At, 1, 0); PG8_STAGE(PG8_SA(0, 1), a2 + hsA, voffA);
            PG8_WAIT_L(8); PG8_BAR; PG8_WAIT_L(0); PG8_MMA(0, 0, At, B0); PG8_BAR; PG8_SCHED;
            PG8_LDB(B1, 1, 1); PG8_STAGE(PG8_SB(1, 0), b3, voffB);
            PG8_BAR; PG8_WAIT_L(0); PG8_MMA(0, 1, At, B1); PG8_BAR;
            PG8_LDA(At, 1, 1); PG8_STAGE(PG8_SA(1, 0), a3, voffA);
            PG8_BAR; PG8_WAIT_L(0); PG8_MMA(1, 0, At, B0); PG8_BAR; PG8_SCHED;
            PG8_STAGE(PG8_SB(1, 1), b3 + hsB, voffB);
            PG8_WAIT_V(6); PG8_BAR; PG8_MMA(1, 1, At, B1); PG8_BAR;
            }
        }
        if constexpr (ALIGN_EPI) { if (wr == 0) PG8_BAR; }
        if constexpr (!Epi::AFTER_DRAIN) { E(acc, cur, wr, wc, fr, fq); S.done(cur); }
        if (!has_next) break;
#pragma unroll
        for (int a = 0; a < 2; ++a)
#pragma unroll
            for (int b = 0; b < 2; ++b)
#pragma unroll
                for (int m = 0; m < 4; ++m)
#pragma unroll
                    for (int n = 0; n < 2; ++n) acc[a][b][m][n] = (f32x4){0.f, 0.f, 0.f, 0.f};
        cur = nxt; cA = nA; cB = nB; ++ui;
        if constexpr (ALIGN_EPI) { if (wr == 1) PG8_BAR; }
    }
    PG8_WAIT_V(0);
    if constexpr (!ALIGN_EPI) { if (wr == 0) PG8_BAR; }
    PG8_BAR;
    if constexpr (Epi::AFTER_DRAIN) { E.fused(acc, cur, wr, wc, fr, fq, lds, wid, lane); S.done(cur); }
#undef PG8_SA
#undef PG8_SB
#undef PG8_STAGE
#undef PG8_LDA
#undef PG8_LDB
#undef PG8_MMA
#undef PG8_WAIT_V
#undef PG8_WAIT_L
#undef PG8_BAR
#undef PG8_SCHED
}
}
namespace attn_body {
using bf16=__hip_bfloat16;
using bf16x8=__attribute__((ext_vector_type(8)))short;
using s16x4=__attribute__((ext_vector_type(4)))short;
using f32x16=__attribute__((ext_vector_type(16)))float;
using u32x4=__attribute__((ext_vector_type(4)))unsigned;
constexpr int D=64,QP=3328,OP=1024;
constexpr int NW=8,QBLK=32,QB=QBLK*NW,KVBLK=64;
constexpr int ATTN_UNIT_ROWS=QB;
__device__ __forceinline__ int crow(int r,int hi){return (r&3)+8*(r>>2)+4*hi;}
#define SBAR() __builtin_amdgcn_sched_barrier(0)
__device__ __forceinline__ void cmask(f32x16&p0,f32x16&p1,int jb,int qrel,int hi){
  const float NEG=-INFINITY; int kb=64*jb+4*hi;
  #pragma unroll
  for(int r=0;r<16;++r){int kv=kb+(r&3)+8*(r>>2); if(kv>qrel)p0[r]=NEG; if(kv+32>qrel)p1[r]=NEG;}
}

constexpr int NSLOT=3, SLOTB=8192;
constexpr int LDS_K=0, LDS_V=NSLOT*SLOTB, LDS_WS=2*NSLOT*SLOTB, LDS_OST=LDS_WS+NW*64*4, LDS_BYTES=LDS_OST+NW*4096;
constexpr float C2=0.125f*1.4426950408889634f;
__device__ __forceinline__ void glds16(const void*gsrc,unsigned lds_dst){unsigned keep;
  asm volatile("s_mov_b32 %0, m0\n\ts_mov_b32 m0, %2\n\ts_nop 0\n\tglobal_load_lds_dwordx4 %1, off\n\ts_mov_b32 m0, %0":"=&s"(keep):"v"(gsrc),"s"(lds_dst):"memory");}
__device__ __forceinline__ float max3f(float a,float b,float c){float r;asm("v_max3_f32 %0, %1, %2, %3":"=v"(r):"v"(a),"v"(b),"v"(c));return r;}
__device__ __forceinline__ float max2f(float a,float b){float r;asm("v_max_f32_e32 %0, %1, %2":"=v"(r):"v"(a),"v"(b));return r;}
__device__ __forceinline__ float fadd_s(float a,float b){float r;asm("v_add_f32_e32 %0, %1, %2":"=v"(r):"v"(a),"v"(b));return r;}
__device__ __forceinline__ float fsub_s(float a,float b){float r;asm("v_sub_f32_e32 %0, %1, %2":"=v"(r):"v"(a),"v"(b));return r;}
typedef float f32x2_t __attribute__((ext_vector_type(2))); typedef __bf16 bf16x2_t __attribute__((ext_vector_type(2)));
__device__ __forceinline__ unsigned cvtpk_s(float lo,float hi){f32x2_t v={lo,hi};bf16x2_t b=__builtin_convertvector(v,bf16x2_t);return __builtin_bit_cast(unsigned,b);}
#define WAIT_BAR(N) asm volatile("s_waitcnt vmcnt(" #N ") lgkmcnt(0)\n\ts_barrier":::"memory")

__device__ __forceinline__ void qkt(f32x16&p0,f32x16&p1,const char*Kslot,const bf16x8*qr,const f32x16&negm,int r32,int hi){
  const char*kb=Kslot+hi*1024+r32*16;
  #pragma unroll
  for(int d0=0;d0<4;++d0){
    const bf16x8 b0=*reinterpret_cast<const bf16x8*>(kb+d0*2048);
    const bf16x8 b1=*reinterpret_cast<const bf16x8*>(kb+d0*2048+512);
    if(d0==0){p0=__builtin_amdgcn_mfma_f32_32x32x16_bf16(b0,qr[0],negm,0,0,0);p1=__builtin_amdgcn_mfma_f32_32x32x16_bf16(b1,qr[0],negm,0,0,0);}
    else{p0=__builtin_amdgcn_mfma_f32_32x32x16_bf16(b0,qr[d0],p0,0,0,0);p1=__builtin_amdgcn_mfma_f32_32x32x16_bf16(b1,qr[d0],p1,0,0,0);}}
}
typedef __attribute__((address_space(3))) const char* lds_cptr;
typedef short v4i16_t __attribute__((ext_vector_type(4)));
__device__ __forceinline__ void kload8(bf16x8*kf,lds_cptr kp){
  kf[0]=*(const __attribute__((address_space(3))) bf16x8*)(kp);      kf[1]=*(const __attribute__((address_space(3))) bf16x8*)(kp+512);
  kf[2]=*(const __attribute__((address_space(3))) bf16x8*)(kp+2048); kf[3]=*(const __attribute__((address_space(3))) bf16x8*)(kp+2560);
  kf[4]=*(const __attribute__((address_space(3))) bf16x8*)(kp+4096); kf[5]=*(const __attribute__((address_space(3))) bf16x8*)(kp+4608);
  kf[6]=*(const __attribute__((address_space(3))) bf16x8*)(kp+6144); kf[7]=*(const __attribute__((address_space(3))) bf16x8*)(kp+6656);
}
__device__ __forceinline__ void kload2(bf16x8*kf,lds_cptr kp,int j){ kf[2*j]=*(const __attribute__((address_space(3))) bf16x8*)(kp+j*2048); kf[2*j+1]=*(const __attribute__((address_space(3))) bf16x8*)(kp+j*2048+512); }
__device__ __forceinline__ s16x4 vtr(lds_cptr p){ return __builtin_bit_cast(s16x4,__builtin_amdgcn_ds_read_tr16_b64_v4i16((__attribute__((address_space(3))) v4i16_t*)p)); }
__device__ __forceinline__ float rowmax(const f32x16&p0,const f32x16&p1){
  float a=max3f(p0[0],p0[1],p1[0]),b=max3f(p0[2],p0[3],p1[1]);a=max3f(a,p1[2],p1[3]);
  #pragma unroll
  for(int r=4;r<16;r+=4){a=max3f(a,p0[r],p0[r+1]);b=max3f(b,p0[r+2],p0[r+3]);a=max3f(a,p1[r],p1[r+1]);b=max3f(b,p1[r+2],p1[r+3]);}
  const float m=max2f(a,b);
  auto rr=__builtin_amdgcn_permlane32_swap(__float_as_uint(m),__float_as_uint(m),false,false);
  return max2f(__uint_as_float(rr[0]),__uint_as_float(rr[1]));
}
__device__ __forceinline__ void pv(f32x16*o,int vb,bf16x8 pa0,bf16x8 pa1,bf16x8 pa2,bf16x8 pa3){
  #pragma unroll
  for(int d0=0;d0<2;++d0){s16x4 lo[4],hi[4];
    #pragma unroll
    for(int ks=0;ks<4;++ks){
      asm volatile("ds_read_b64_tr_b16 %0,%1 offset:%c2":"=&v"(lo[ks]):"v"(vb),"i"(d0*4096+ks*1024):"memory");
      asm volatile("ds_read_b64_tr_b16 %0,%1 offset:%c2":"=&v"(hi[ks]):"v"(vb),"i"(d0*4096+ks*1024+512):"memory");}
    asm volatile("s_waitcnt lgkmcnt(0)":::"memory");SBAR();
    #define PK(k) (bf16x8){lo[k][0],lo[k][1],lo[k][2],lo[k][3],hi[k][0],hi[k][1],hi[k][2],hi[k][3]}
    o[d0]=__builtin_amdgcn_mfma_f32_32x32x16_bf16(pa0,PK(0),o[d0],0,0,0);
    o[d0]=__builtin_amdgcn_mfma_f32_32x32x16_bf16(pa1,PK(1),o[d0],0,0,0);
    o[d0]=__builtin_amdgcn_mfma_f32_32x32x16_bf16(pa2,PK(2),o[d0],0,0,0);
    o[d0]=__builtin_amdgcn_mfma_f32_32x32x16_bf16(pa3,PK(3),o[d0],0,0,0);
    #undef PK
  }
}

#ifndef ATTN_STORE16
#define ATTN_STORE16(p,v) (*(u32x4*)(p)=(v))
#endif
template<int THRL> __device__ __forceinline__ void attn_unit(const bf16*Qu,const bf16*__restrict__ Kc,const bf16*__restrict__ Vc,bf16*Ou,int krow0,int nt_main,int krow1,int NT,char*shm){
  const int tid=tid_now(),lane=tid&63,r32=lane&31,hi=lane>>5; const int wid=__builtin_amdgcn_readfirstlane(tid>>6);
  const bf16*Qw=Qu+(long)(wid*QBLK)*QP;
  const unsigned lds0=(unsigned)(uintptr_t)shm;
  float*wsf=(float*)(shm+LDS_WS)+wid*64;
  const bf16*ksrc=Kc+(long)lane*QP+wid*8;
  const bf16*vsrc=Vc+(long)(16*(wid&3)+(lane>>2))*QP+(wid>>2)*32+(lane&3)*8;
  const unsigned kdst=lds0+LDS_K+wid*1024, vdst=lds0+LDS_V+wid*1024;
  #define KROW(t) (((t)<nt_main)?(krow0+(t)*KVBLK):(krow1+((t)-nt_main)*KVBLK))
  #define DMA_K(t,slot) glds16(ksrc+(long)KROW(t)*QP,(unsigned)__builtin_amdgcn_readfirstlane(kdst+(slot)))
  #define DMA_V(t,slot) glds16(vsrc+(long)KROW(t)*QP,(unsigned)__builtin_amdgcn_readfirstlane(vdst+(slot)))
  const int vb0=(int)(lds0+LDS_V)+((lane>>4)&1)*32+(lane&3)*8+(4*hi+((lane&15)>>2))*64;
  const char*Kbase=shm+LDS_K; bf16x8 kf[8];
  const lds_cptr shm3=(lds_cptr)shm; const lds_cptr kp0=shm3+LDS_K+hi*1024+r32*16; const lds_cptr vp0=shm3+LDS_V+((lane>>4)&1)*32+(lane&3)*8+(4*hi+((lane&15)>>2))*64;
  DMA_K(0,0);DMA_V(0,0);DMA_K(1,SLOTB);
  bf16x8 qr[4];
  #pragma unroll
  for(int d0=0;d0<4;++d0)qr[d0]=*reinterpret_cast<const bf16x8*>(&Qw[(long)r32*QP+d0*16+hi*8]);
  float mhat=0.f,l_reg=0.f;f32x16 o[2];o[0]=f32x16{};o[1]=f32x16{};f32x16 negm=f32x16{};asm volatile("":"+v"(negm));
  const int qrel=wid*QBLK+r32;
  #define CMASK(P0,P1,t) do{}while(0)
  bool resc=false;
  #define START(P0,P1) do{ const float rm=rowmax(P0,P1); resc=false; \
    { const float dl=rm; mhat=fadd_s(mhat,dl); \
      _Pragma("unroll") for(int r=0;r<16;++r){P0[r]=fsub_s(P0[r],dl);P1[r]=fsub_s(P1[r],dl);} \
      _Pragma("unroll") for(int r=0;r<16;++r)negm[r]=-mhat; asm volatile("":"+v"(negm)); } \
    _Pragma("unroll") for(int r=0;r<16;++r)P0[r]=__builtin_amdgcn_exp2f(P0[r]); }while(0)
  #define RESC() do{ if(resc){ asm volatile("s_waitcnt lgkmcnt(0)":::"memory"); \
      _Pragma("unroll") for(int d_=0;d_<2;++d_) _Pragma("unroll") for(int r=0;r<16;++r)o[d_][r]*=wsf[crow(r,hi)]; } }while(0)
  f32x16 pA0,pA1,pB0,pB1;
  int sl_prev=0,sl_cur=0,sl_next=SLOTB;
  #define ROT() do{sl_prev=sl_cur;sl_cur=sl_next;sl_next=(sl_next==(NSLOT-1)*SLOTB)?0:sl_next+SLOTB;}while(0)
  DMA_K(2,2*SLOTB);
  WAIT_BAR(3);
  qkt(pA0,pA1,Kbase,qr,negm,r32,hi);asm volatile("s_nop 15\n\ts_nop 7":"+v"(pA0),"+v"(pA1));CMASK(pA0,pA1,0);
  START(pA0,pA1);
  _Pragma("unroll") for(int r=0;r<16;++r)pA1[r]=__builtin_amdgcn_exp2f(pA1[r]);
  WAIT_BAR(0);
  DMA_K(3,0);DMA_V(1,SLOTB);
  ROT();
  kload8(kf,kp0+sl_cur);
  WAIT_BAR(2);
  s16x4 vlo[8],vhi[8]; u32x4 pw0,pw1,pw2,pw3;
  #define PKW(P,B) cvtpk_s(P[B],P[B+1])
  #define PAF(k) __builtin_bit_cast(bf16x8,pw##k)
  #define VFR(i) (bf16x8){vlo[i][0],vlo[i][1],vlo[i][2],vlo[i][3],vhi[i][0],vhi[i][1],vhi[i][2],vhi[i][3]}
  #define PIN(x) asm volatile("":"+v"(x))
  #define MX3(a,b,c) __builtin_fmaxf(__builtin_fmaxf((a),(b)),(c))
  #define GAPA(MF,A0,A1,A2,A3,W0,W1,PW) do{ MF; sacc+=A0; sacc+=A1; sacc+=A2; sacc+=A3; PIN(sacc); W0; W1; PIN(PW); SBAR(); }while(0)
  #define EX(v) __builtin_amdgcn_exp2f(v)
  #define GAPB(MF,X,B) do{ MF; X[B]=EX(X[B]); X[B+1]=EX(X[B+1]); X[B+2]=EX(X[B+2]); X[B+3]=EX(X[B+3]); PIN(X); SBAR(); }while(0)
  #define VRD(i) do{ vlo[i]=vtr(vp_+(((i)>>2)*4096+((i)&3)*1024)); vhi[i]=vtr(vp_+(((i)>>2)*4096+((i)&3)*1024+512)); }while(0)
  #define KRD(G,j) do{ if(G){ kload2(kf,kp0+sl_next,j); SBAR(); } }while(0)
  #define STEP(C0,C1,P0,P1,t,GK,GV,GL) do{ SBAR(); \
    const lds_cptr vp_=vp0+sl_prev; \
    VRD(0); SBAR(); float sacc=(P0[0]+P0[1]); \
    GAPA(C0=__builtin_amdgcn_mfma_f32_32x32x16_bf16(kf[0],qr[0],negm,0,0,0), P0[2],P0[3],P0[4],P0[5],     pw0[0]=PKW(P0,0), pw0[1]=PKW(P0,2), pw0); \
    VRD(4); SBAR(); GAPA(C1=__builtin_amdgcn_mfma_f32_32x32x16_bf16(kf[1],qr[0],negm,0,0,0), P0[6],P0[7],P0[8],P0[9],     pw0[2]=PKW(P0,4), pw0[3]=PKW(P0,6), pw0); \
    VRD(1); SBAR(); GAPA(C0=__builtin_amdgcn_mfma_f32_32x32x16_bf16(kf[2],qr[1],C0,0,0,0),   P0[10],P0[11],P0[12],P0[13], pw1[0]=PKW(P0,8), pw1[1]=PKW(P0,10), pw1); \
    VRD(5); SBAR(); GAPA(C1=__builtin_amdgcn_mfma_f32_32x32x16_bf16(kf[3],qr[1],C1,0,0,0),   P0[14],P0[15],P1[0],P1[1],   pw1[2]=PKW(P0,12),pw1[3]=PKW(P0,14), pw1); \
    VRD(2); SBAR(); GAPA(C0=__builtin_amdgcn_mfma_f32_32x32x16_bf16(kf[4],qr[2],C0,0,0,0),   P1[2],P1[3],P1[4],P1[5],     pw2[0]=PKW(P1,0), pw2[1]=PKW(P1,2), pw2); \
    VRD(6); SBAR(); GAPA(C1=__builtin_amdgcn_mfma_f32_32x32x16_bf16(kf[5],qr[2],C1,0,0,0),   P1[6],P1[7],P1[8],P1[9],     pw2[2]=PKW(P1,4), pw2[3]=PKW(P1,6), pw2); \
    VRD(3); SBAR(); GAPA(C0=__builtin_amdgcn_mfma_f32_32x32x16_bf16(kf[6],qr[3],C0,0,0,0),   P1[10],P1[11],P1[12],P1[13], pw3[0]=PKW(P1,8), pw3[1]=PKW(P1,10), pw3); \
    VRD(7); SBAR(); GAPA(C1=__builtin_amdgcn_mfma_f32_32x32x16_bf16(kf[7],qr[3],C1,0,0,0),   P1[14],P1[15],0.f,0.f,       pw3[2]=PKW(P1,12),pw3[3]=PKW(P1,14), pw3); \
    l_reg+=sacc; \
    if(GK){DMA_K((t)+3,sl_cur);} if(GV){DMA_V((t)+1,sl_next);} \
    CMASK(C0,C1,t); \
    { float a=MX3(C0[0],C0[1],C1[0]),b=MX3(C0[2],C0[3],C1[1]); a=MX3(a,C1[2],C1[3]); \
      _Pragma("unroll") for(int r=4;r<16;r+=4){a=MX3(a,C0[r],C0[r+1]);b=MX3(b,C0[r+2],C0[r+3]);a=MX3(a,C1[r],C1[r+1]);b=MX3(b,C1[r+2],C1[r+3]);} \
      float rm=__builtin_fmaxf(a,b); { auto rr=__builtin_amdgcn_permlane32_swap(__float_as_uint(rm),__float_as_uint(rm),false,false); rm=__builtin_fmaxf(__uint_as_float(rr[0]),__uint_as_float(rr[1])); } \
      resc=false; \
      if(__builtin_expect(__any(rm>(float)THRL),0)){ const float dl=__builtin_fmaxf(rm,0.f); mhat+=dl; \
        _Pragma("unroll") for(int r=0;r<16;++r){C0[r]-=dl;C1[r]-=dl;} \
        _Pragma("unroll") for(int r=0;r<16;++r)negm[r]=-mhat; asm volatile("":"+v"(negm)); \
        const float f=__builtin_amdgcn_exp2f(-dl); l_reg*=f; if(hi==0)wsf[r32]=f; resc=true; } } \
    SBAR(); \
    GAPB(o[0]=__builtin_amdgcn_mfma_f32_32x32x16_bf16(PAF(0),VFR(0),o[0],0,0,0), C0,0); \
    GAPB(o[1]=__builtin_amdgcn_mfma_f32_32x32x16_bf16(PAF(0),VFR(4),o[1],0,0,0), C0,4); \
    KRD(GL,0); GAPB(o[0]=__builtin_amdgcn_mfma_f32_32x32x16_bf16(PAF(1),VFR(1),o[0],0,0,0), C0,8); \
    KRD(GL,1); GAPB(o[1]=__builtin_amdgcn_mfma_f32_32x32x16_bf16(PAF(1),VFR(5),o[1],0,0,0), C0,12); \
    KRD(GL,2); GAPB(o[0]=__builtin_amdgcn_mfma_f32_32x32x16_bf16(PAF(2),VFR(2),o[0],0,0,0), C1,0); \
    KRD(GL,3); GAPB(o[1]=__builtin_amdgcn_mfma_f32_32x32x16_bf16(PAF(2),VFR(6),o[1],0,0,0), C1,4); \
    GAPB(o[0]=__builtin_amdgcn_mfma_f32_32x32x16_bf16(PAF(3),VFR(3),o[0],0,0,0), C1,8); \
    GAPB(o[1]=__builtin_amdgcn_mfma_f32_32x32x16_bf16(PAF(3),VFR(7),o[1],0,0,0), C1,12); \
    }while(0)
  int t=1;
  #undef CMASK
  #define CMASK(P0,P1,t) do{}while(0)
  for(;t+5<NT;t+=2){
    STEP(pB0,pB1,pA0,pA1,t,true,true,true);     WAIT_BAR(2); RESC(); ROT();
    STEP(pA0,pA1,pB0,pB1,t+1,true,true,true);   WAIT_BAR(2); RESC(); ROT();
  }
  #undef CMASK
  #define CMASK(P0,P1,t) do{}while(0)
  #define ENDW(tt) do{ if((tt)+3<NT){WAIT_BAR(2);} else if((tt)+2<NT){WAIT_BAR(1);} else {WAIT_BAR(0);} }while(0)
  for(;t+1<NT;t+=2){
    STEP(pB0,pB1,pA0,pA1,t,(t+3<NT),(t+1<NT),(t+1<NT));       ENDW(t);   RESC(); ROT();
    STEP(pA0,pA1,pB0,pB1,t+1,(t+4<NT),(t+2<NT),(t+2<NT));     ENDW(t+1); RESC(); ROT();
  }
  STEP(pB0,pB1,pA0,pA1,NT-1,false,false,false); RESC();
  { float sacc=pB0[0]+pB0[1]; _Pragma("unroll") for(int r=2;r<16;++r)sacc+=pB0[r]; _Pragma("unroll") for(int r=0;r<16;++r)sacc+=pB1[r]; l_reg+=sacc;
    pw0=(u32x4){PKW(pB0,0),PKW(pB0,2),PKW(pB0,4),PKW(pB0,6)};pw1=(u32x4){PKW(pB0,8),PKW(pB0,10),PKW(pB0,12),PKW(pB0,14)};pw2=(u32x4){PKW(pB1,0),PKW(pB1,2),PKW(pB1,4),PKW(pB1,6)};pw3=(u32x4){PKW(pB1,8),PKW(pB1,10),PKW(pB1,12),PKW(pB1,14)};
    SBAR(); pv(o,vb0+sl_cur,PAF(0),PAF(1),PAF(2),PAF(3)); }
  #undef PKW
  #undef PAF
  #undef VFR
  #undef PIN
  #undef MX3
  #undef GAPA
  #undef GAPB
  #undef EX
  #undef VRD
  #undef KRD
  #undef STEP
  #undef ENDW
  {auto rr=__builtin_amdgcn_permlane32_swap(__float_as_uint(l_reg),__float_as_uint(l_reg),false,false);l_reg=__uint_as_float(rr[0])+__uint_as_float(rr[1]);}
  if(hi==0)wsf[32+r32]=l_reg;asm volatile("s_waitcnt lgkmcnt(0)":::"memory");
  float rli[16];
  #pragma unroll
  for(int r=0;r<16;++r)rli[r]=__builtin_amdgcn_rcpf(wsf[32+crow(r,hi)]);
  bf16*Ow=Ou+(long)(wid*QBLK)*OP;
  { bf16*stg=(bf16*)(shm+LDS_OST)+wid*2048;
    #pragma unroll
    for(int r=0;r<16;++r){const int orow=crow(r,hi);
      #pragma unroll
      for(int d0=0;d0<2;++d0)stg[orow*64+d0*32+r32]=__float2bfloat16(o[d0][r]*rli[r]);}
    asm volatile("s_waitcnt lgkmcnt(0)":::"memory");
    #pragma unroll
    for(int i=0;i<4;++i){const int row=i*8+(lane>>3),ch=lane&7; const u32x4 v=*(const u32x4*)(stg+row*64+ch*8); ATTN_STORE16(Ow+(long)row*OP+ch*8,v);} }
  asm volatile("s_waitcnt lgkmcnt(0)\n\ts_barrier":::"memory");
  #undef DMA_K
  #undef KROW
  #undef DMA_V
  #undef CMASK
  #undef START
  #undef RESC
  #undef ROT
}

template<int THRL> __device__ __forceinline__ void attn_unit2(const bf16*Qu,const bf16*__restrict__ Kc,const bf16*__restrict__ Vc,bf16*Ou,int krow0,int nt_main,int krow1,int NT,char*shm){
  const int tid=tid_now(),lane=tid&63,r32=lane&31,hi=lane>>5; const int wid=__builtin_amdgcn_readfirstlane(tid>>6);
  constexpr int KS=8192,VS=16384,L_K=0,L_V=3*KS,L_WS=L_V+3*VS,L_OST=L_WS+NW*64*4;
  const bf16*Qw=Qu+(long)(wid*QBLK)*QP;
  const unsigned lds0=(unsigned)(uintptr_t)shm;
  float*wsf=(float*)(shm+L_WS)+wid*64;
  const bf16*ksrc=Kc+(long)lane*QP+wid*8;
  const bf16*vsrc=Vc+(long)(16*(wid&3)+(lane>>2))*QP+(wid>>2)*32+(lane&3)*8;
  const unsigned kdst=lds0+L_K+wid*1024, vdst=lds0+L_V+wid*1024;
  #define KROW2(t) (((t)<nt_main)?(krow0+(t)*KVBLK):(krow1+((t)-nt_main)*KVBLK))
  #define DMA2(t,s) do{ const long ro_=(long)KROW2(t)*QP; glds16(ksrc+ro_,(unsigned)__builtin_amdgcn_readfirstlane(kdst+(s)*KS)); \
      glds16(vsrc+ro_,(unsigned)__builtin_amdgcn_readfirstlane(vdst+(s)*VS)); glds16(vsrc+ro_+64,(unsigned)__builtin_amdgcn_readfirstlane(vdst+(s)*VS+8192)); }while(0)
  const int vb0=(int)(lds0+L_V)+((lane>>4)&1)*32+(lane&3)*8+(4*hi+((lane&15)>>2))*64;
  DMA2(0,0); if(NT>1) DMA2(1,1);
  bf16x8 qr[4];
  #pragma unroll
  for(int d0=0;d0<4;++d0)qr[d0]=*reinterpret_cast<const bf16x8*>(&Qw[(long)r32*QP+d0*16+hi*8]);
  float mhat=0.f,l_reg=0.f; f32x16 o[4]; o[0]=f32x16{};o[1]=f32x16{};o[2]=f32x16{};o[3]=f32x16{}; f32x16 negm=f32x16{};
  int sl=0;
  for(int t=0;t<NT;++t){
    if(t+1<NT) asm volatile("s_waitcnt vmcnt(3) lgkmcnt(0)\n\ts_barrier":::"memory"); else asm volatile("s_waitcnt vmcnt(0) lgkmcnt(0)\n\ts_barrier":::"memory");
    if(t+2<NT){ const int s2=(sl==0)?2:sl-1; DMA2(t+2,s2); }
    f32x16 p0,p1; qkt(p0,p1,shm+L_K+sl*KS,qr,negm,r32,hi);
    float rm=p0[0];
    #pragma unroll
    for(int r=0;r<16;++r){ rm=__builtin_fmaxf(rm,p0[r]); rm=__builtin_fmaxf(rm,p1[r]); }
    { auto rr=__builtin_amdgcn_permlane32_swap(__float_as_uint(rm),__float_as_uint(rm),false,false); rm=__builtin_fmaxf(__uint_as_float(rr[0]),__uint_as_float(rr[1])); }
    bool resc=false;
    if(t==0){ mhat=rm;
      #pragma unroll
      for(int r=0;r<16;++r){p0[r]-=rm;p1[r]-=rm;}
      #pragma unroll
      for(int r=0;r<16;++r)negm[r]=-mhat; }
    else if(__any(rm>(float)THRL)){ const float dl=__builtin_fmaxf(rm,0.f); mhat+=dl;
      #pragma unroll
      for(int r=0;r<16;++r){p0[r]-=dl;p1[r]-=dl;}
      #pragma unroll
      for(int r=0;r<16;++r)negm[r]=-mhat;
      const float f=__builtin_amdgcn_exp2f(-dl); l_reg*=f; if(hi==0)wsf[r32]=f; resc=true; }
    float sacc=0.f;
    #pragma unroll
    for(int r=0;r<16;++r){ p0[r]=__builtin_amdgcn_exp2f(p0[r]); p1[r]=__builtin_amdgcn_exp2f(p1[r]); sacc+=p0[r]+p1[r]; }
    l_reg+=sacc;
    u32x4 pw0,pw1,pw2,pw3;
    pw0=(u32x4){cvtpk_s(p0[0],p0[1]),cvtpk_s(p0[2],p0[3]),cvtpk_s(p0[4],p0[5]),cvtpk_s(p0[6],p0[7])};
    pw1=(u32x4){cvtpk_s(p0[8],p0[9]),cvtpk_s(p0[10],p0[11]),cvtpk_s(p0[12],p0[13]),cvtpk_s(p0[14],p0[15])};
    pw2=(u32x4){cvtpk_s(p1[0],p1[1]),cvtpk_s(p1[2],p1[3]),cvtpk_s(p1[4],p1[5]),cvtpk_s(p1[6],p1[7])};
    pw3=(u32x4){cvtpk_s(p1[8],p1[9]),cvtpk_s(p1[10],p1[11]),cvtpk_s(p1[12],p1[13]),cvtpk_s(p1[14],p1[15])};
    if(resc){ asm volatile("s_waitcnt lgkmcnt(0)":::"memory");
      #pragma unroll
      for(int r=0;r<16;++r){ const float f=wsf[crow(r,hi)];
        #pragma unroll
        for(int d_=0;d_<4;++d_) o[d_][r]*=f; } }
    pv(o,  vb0+sl*VS,     __builtin_bit_cast(bf16x8,pw0),__builtin_bit_cast(bf16x8,pw1),__builtin_bit_cast(bf16x8,pw2),__builtin_bit_cast(bf16x8,pw3));
    pv(o+2,vb0+sl*VS+8192,__builtin_bit_cast(bf16x8,pw0),__builtin_bit_cast(bf16x8,pw1),__builtin_bit_cast(bf16x8,pw2),__builtin_bit_cast(bf16x8,pw3));
    sl=(sl==2)?0:sl+1;
  }
  {auto rr=__builtin_amdgcn_permlane32_swap(__float_as_uint(l_reg),__float_as_uint(l_reg),false,false);l_reg=__uint_as_float(rr[0])+__uint_as_float(rr[1]);}
  if(hi==0)wsf[32+r32]=l_reg; asm volatile("s_waitcnt lgkmcnt(0)":::"memory");
  float rli[16];
  #pragma unroll
  for(int r=0;r<16;++r)rli[r]=__builtin_amdgcn_rcpf(wsf[32+crow(r,hi)]);
  bf16*Ow=Ou+(long)(wid*QBLK)*OP; bf16*stg=(bf16*)(shm+L_OST)+wid*2048;
  #pragma unroll
  for(int e=0;e<2;++e){
    #pragma unroll
    for(int r=0;r<16;++r){const int orow=crow(r,hi);
      #pragma unroll
      for(int d0=0;d0<2;++d0)stg[orow*64+d0*32+r32]=__float2bfloat16(o[2*e+d0][r]*rli[r]);}
    asm volatile("s_waitcnt lgkmcnt(0)":::"memory");
    #pragma unroll
    for(int i=0;i<4;++i){const int row=i*8+(lane>>3),ch=lane&7; const u32x4 v=*(const u32x4*)(stg+row*64+ch*8); ATTN_STORE16(Ow+(long)row*OP+e*64+ch*8,v);}
    asm volatile("s_waitcnt lgkmcnt(0)":::"memory");
  }
  asm volatile("s_waitcnt lgkmcnt(0)\n\ts_barrier":::"memory");
  #undef KROW2
  #undef DMA2
}
constexpr int ATTN_LDS_BYTES=LDS_BYTES;
#undef SBAR
#undef WAIT_BAR
}

#define LAS __attribute__((address_space(3)))
typedef unsigned short bf16;
typedef float f32x4 __attribute__((ext_vector_type(4)));
typedef unsigned u32x4 __attribute__((ext_vector_type(4)));
typedef unsigned u32x2 __attribute__((ext_vector_type(2)));
using pg8::cvt_pk_bf16; using pg8::bf_lo; using pg8::bf_hi; using pg8::fsigmoid; using pg8::fsilu;

constexpr int NWAVES = 8, NTHR = 512;
constexpr int DM = 1024, NX = 16384, NCTX = 1024, MT = NX + NCTX, SEQ = 4096, CTXL = 256, FF = 2816, PXW = 3328, MODW = 9216, INC = 7424;
constexpr int A_OFF = 0, B_OFF = 768, Q_OFF = 1280, K_OFF = 1792, V_OFF = 2304, D_OFF = 2816, G_OFF = 3328;
constexpr float EPS = 1e-6f;
constexpr float C2 = 0.125f * 1.4426950408889634f;
constexpr int LDS_BYTES = 147456;

constexpr size_t MiB = 1u << 20;
constexpr size_t WS_MOD = 0;
constexpr size_t WS_ROPE = 512 * 1024;
constexpr size_t WS_LAM = WS_ROPE + 16384;
constexpr size_t WS_BAR = 640 * 1024;
constexpr size_t WS_W = 1 * MiB;
constexpr size_t LW_UP1 = 0, LW_DN1 = LW_UP1 + (size_t)5632 * 1024, LW_UP2 = LW_DN1 + (size_t)1024 * 2816, LW_DN2 = LW_UP2 + (size_t)5632 * 1024,
                 LW_WIN = LW_DN2 + (size_t)1024 * 2816, LW_AO = LW_WIN + (size_t)INC * 1024, LW_BO = LW_AO + 262144, LW_DO = LW_BO + 262144,
                 LW_CO = LW_DO + 262144, LW_O = LW_CO + 524288, LW_TOTAL = LW_O + 1048576;
static_assert(LW_TOTAL * 2 == 52 * MiB, "weights per layer");
constexpr size_t WS_HN = 105 * MiB;
constexpr size_t WS_PX = 139 * MiB;
constexpr size_t WS_OB = 250 * MiB;
constexpr size_t WS_GS = 284 * MiB;
constexpr size_t WS_ACTD = 316 * MiB;
constexpr size_t WS_CTX = 325 * MiB;
constexpr size_t WS_MGP = 329 * MiB;
constexpr size_t WS_END = 337 * MiB;
constexpr size_t WS_PART = WS_GS;
static_assert(WS_HN + (size_t)MT * 1024 * 2 <= WS_PX && WS_PX + (size_t)MT * PXW * 2 <= WS_OB && WS_OB + (size_t)MT * 1024 * 2 <= WS_GS && WS_ACTD + (size_t)MT * 256 * 2 <= WS_CTX, "ws map");

#define GAS __attribute__((address_space(1)))
#define XB_TMO      128
#define XB_XCNT(j)  (256  + 64 * (j))
#define XB_XSUB(j)  (1280 + 64 * (j))
#define XB_XGEN(j)  (2304 + 64 * (j))
#define XB_TOP      3328
#define XB_TOPGEN   3392
#define XCD_BAR_WORDS 3456
#define XB_SPIN_CAP (1u << 18)

__device__ __forceinline__ unsigned xb_ld(unsigned* p)              { return __hip_atomic_load(p, __ATOMIC_RELAXED, __HIP_MEMORY_SCOPE_AGENT); }
__device__ __forceinline__ unsigned xb_add(unsigned* p, unsigned v) { return __hip_atomic_fetch_add(p, v, __ATOMIC_RELAXED, __HIP_MEMORY_SCOPE_AGENT); }
__device__ __forceinline__ unsigned xb_xcc_id() { return (unsigned)__builtin_amdgcn_s_getreg((3 << 11) | 20) & 0xFu; }
#define XB_SPIN(cond, bar) do { unsigned _sp = 0; while (cond) { __builtin_amdgcn_s_sleep(1); \
    if ((++_sp & 255u) == 0u) { if (xb_ld(&(bar)[XB_TMO])) break; if (_sp > XB_SPIN_CAP) { atomicAdd(&(bar)[XB_TMO], 1u); break; } } } } while (0)

struct XcdBarrier {
    unsigned* bar; unsigned x;
    volatile LAS unsigned* st;
};

__device__ __forceinline__ XcdBarrier xcd_barrier_post(unsigned* bar, volatile LAS unsigned* st) {
    XcdBarrier b; b.bar = bar; b.x = xb_xcc_id(); b.st = st;
    if (threadIdx.x == 0) (void)xb_add(&bar[XB_XCNT(b.x)], 1u);
    return b;
}
__device__ __forceinline__ void xcd_barrier_complete(unsigned* bar, unsigned x, unsigned& nloc, unsigned& nx) {
    const unsigned G = gridDim.x * gridDim.y * gridDim.z;
    unsigned sum, cnt, mine, sp = 0u;
    for (;;) {
        sum = 0u; cnt = 0u; mine = 0u;
#pragma unroll
        for (unsigned j = 0; j < 16; ++j) { const unsigned c = xb_ld(&bar[XB_XCNT(j)]); sum += c; cnt += (c > 0u) ? 1u : 0u; mine = (j == x) ? c : mine; }
        if (sum == G) break;
        __builtin_amdgcn_s_sleep(1);
        if ((++sp & 255u) == 0u) { if (xb_ld(&bar[XB_TMO])) break; if (sp > XB_SPIN_CAP) { atomicAdd(&bar[XB_TMO], 1u); break; } }
    }
    nloc = mine > 0u ? mine : 1u; nx = cnt > 0u ? cnt : 1u;
}

__device__ __forceinline__ void xcd_barrier(const XcdBarrier& b) {
    asm volatile("s_waitcnt vmcnt(0)" ::: "memory");
    __syncthreads();
    if (threadIdx.x == 0) {
        unsigned* bar = b.bar;
        __builtin_amdgcn_s_waitcnt(0);
        unsigned nloc = b.st[0], nx = b.st[1];
        if (nloc == 0u) { xcd_barrier_complete(bar, b.x, nloc, nx); b.st[0] = nloc; b.st[1] = nx; }
        const unsigned old = xb_add(&bar[XB_XSUB(b.x)], 1u);
        const unsigned gen = old / nloc;
        if (old + 1u == (gen + 1u) * nloc) {
            __builtin_amdgcn_fence(__ATOMIC_RELEASE, "agent");
            asm volatile("s_waitcnt vmcnt(0)" ::: "memory");
            const unsigned og = xb_add(&bar[XB_TOP], 1u);
            const unsigned tg = og / nx;
            if (og + 1u == (tg + 1u) * nx) xb_add(&bar[XB_TOPGEN], 1u);
            else XB_SPIN(xb_ld(&bar[XB_TOPGEN]) == tg, bar);
            __builtin_amdgcn_fence(__ATOMIC_ACQUIRE, "agent");
            xb_add(&bar[XB_XGEN(b.x)], 1u);
            asm volatile("s_waitcnt vmcnt(0)" ::: "memory");
        } else {
            XB_SPIN(xb_ld(&bar[XB_XGEN(b.x)]) == gen, bar);
            __builtin_amdgcn_fence(__ATOMIC_ACQUIRE, "agent");
            asm volatile("s_waitcnt vmcnt(0)" ::: "memory");
        }
    }
    __syncthreads();
}

struct Params { const float* in[29]; float* out; unsigned char* ws; int ph_lo, ph_hi; };
typedef __attribute__((address_space(4))) const Params* KP;

__device__ __forceinline__ float wave_sum(float v) {
#pragma unroll
    for (int o = 1; o < 64; o <<= 1) v += __shfl_xor(v, o);
    return v;
}

__device__ __forceinline__ void transpose_item(const float* W, int K, int N, bf16* WT, LAS float* scr, int k0, int n0, int drow0, int lane) {
#pragma unroll 8
    for (int i = 0; i < 32; ++i) { const int kk = 2 * i + (lane >> 5); scr[kk * 33 + (lane & 31)] = W[(size_t)(k0 + kk) * N + n0 + (lane & 31)]; }
    asm volatile("s_waitcnt lgkmcnt(0)" ::: "memory");
    const int c = lane & 7;
#pragma unroll
    for (int j = 0; j < 4; ++j) { const int n = (lane >> 3) + 8 * j; const LAS float* s = scr + (8 * c) * 33 + n;
        u32x4 o; o.x = cvt_pk_bf16(s[0 * 33], s[1 * 33]); o.y = cvt_pk_bf16(s[2 * 33], s[3 * 33]); o.z = cvt_pk_bf16(s[4 * 33], s[5 * 33]); o.w = cvt_pk_bf16(s[6 * 33], s[7 * 33]);
        *(u32x4*)(WT + (size_t)(drow0 + n) * K + k0 + 8 * c) = o; }
    asm volatile("s_waitcnt lgkmcnt(0)" ::: "memory");
}
__device__ __forceinline__ bool transpose_mat(int& r, const float* W, int K, int N, bf16* WT, int mode, LAS float* scr, int lane) {
    const int nblk = N / 32, items = (K / 64) * nblk;
    if (r >= items) { r -= items; return false; }
    const int kb = r / nblk, nb = r % nblk, n0 = 32 * nb;
    const int drow0 = (mode == 0) ? n0 : (256 * (n0 >> 7) + (n0 & 127) + (mode == 2 ? 128 : 0));
    transpose_item(W, K, N, WT, scr, 64 * kb, n0, drow0, lane);
    return true;
}

__device__ __forceinline__ void convert_weights(KP pp, unsigned char* lds_g, int l, int widx, int nw, int lane, int wave) {
    LAS float* scr = (LAS float*)((LAS unsigned char*)lds_g + wave * 16384);
    constexpr int ITEMS_L = 13312;
    bf16* WB = (bf16*)(pp->ws + WS_W) + (size_t)l * LW_TOTAL;
    const size_t offf = (size_t)l * 1024 * 2816;
    for (int it = widx; it < ITEMS_L; it += nw) {
        int r = it;
        if (transpose_mat(r, pp->in[7] + offf, 1024, 2816, WB + LW_UP1, 1, scr, lane)) continue;
        if (transpose_mat(r, pp->in[8] + offf, 1024, 2816, WB + LW_UP1, 2, scr, lane)) continue;
        if (transpose_mat(r, pp->in[9] + offf, 2816, 1024, WB + LW_DN1, 0, scr, lane)) continue;
        if (transpose_mat(r, pp->in[10] + offf, 1024, 2816, WB + LW_UP2, 1, scr, lane)) continue;
        if (transpose_mat(r, pp->in[11] + offf, 1024, 2816, WB + LW_UP2, 2, scr, lane)) continue;
        if (transpose_mat(r, pp->in[12] + offf, 2816, 1024, WB + LW_DN2, 0, scr, lane)) continue;
        if (transpose_mat(r, pp->in[13] + (size_t)l * 1024 * INC, 1024, INC, WB + LW_WIN, 0, scr, lane)) continue;
        if (transpose_mat(r, pp->in[15] + (size_t)l * 262144, 256, 1024, WB + LW_AO, 0, scr, lane)) continue;
        if (transpose_mat(r, pp->in[18] + (size_t)l * 262144, 256, 1024, WB + LW_BO, 0, scr, lane)) continue;
        if (transpose_mat(r, pp->in[26] + (size_t)l * 262144, 256, 1024, WB + LW_DO, 0, scr, lane)) continue;
        if (transpose_mat(r, pp->in[21] + (size_t)l * 524288, 512, 1024, WB + LW_CO, 0, scr, lane)) continue;
        transpose_mat(r, pp->in[27] + (size_t)l * 1048576, 1024, 1024, WB + LW_O, 0, scr, lane);
    }
}

__device__ __forceinline__ void prologue(KP pp, unsigned char* lds_g, int tid, int lane, int wave, int vcu, int G) {
    LAS unsigned char* lds = (LAS unsigned char*)lds_g;
    convert_weights(pp, lds_g, 0, vcu * NWAVES + wave, G * NWAVES, lane, wave);
    __syncthreads();
    LAS float* sc = (LAS float*)lds;
    LAS float* part = (LAS float*)(lds + 32768);
    for (int i = tid; i < 5 * 1024; i += NTHR) { const int s = i >> 10, k = i & 1023; const float v = (s < 4) ? pp->in[1][s * 1024 + k] : pp->in[3][k]; sc[i] = fsilu(v); }
    __syncthreads();
    float* MOD = (float*)(pp->ws + WS_MOD);
    for (int it = vcu; it < 2 * 72; it += G) {
        const int l = it / 72, nb = it % 72; const int n = nb * 128 + 2 * lane;
        const float* wa = pp->in[4] + (size_t)l * 1024 * MODW + n;
        typedef float f32x2 __attribute__((ext_vector_type(2)));
        f32x2 a0 = {0.f, 0.f}, a1 = a0, a2 = a0, a3 = a0, a4 = a0;
#pragma unroll 8
        for (int kk = 0; kk < 128; ++kk) { const int k = wave * 128 + kk; const f32x2 w = *(const f32x2*)(wa + (size_t)k * MODW);
            a0 += w * sc[k]; a1 += w * sc[1024 + k]; a2 += w * sc[2048 + k]; a3 += w * sc[3072 + k]; a4 += w * sc[4096 + k]; }
        LAS f32x2* part2 = (LAS f32x2*)part;
        part2[(wave * 5 + 0) * 64 + lane] = a0; part2[(wave * 5 + 1) * 64 + lane] = a1; part2[(wave * 5 + 2) * 64 + lane] = a2; part2[(wave * 5 + 3) * 64 + lane] = a3; part2[(wave * 5 + 4) * 64 + lane] = a4;
        __syncthreads();
        if (tid < 320) { const int s = tid >> 6, cl = tid & 63; f32x2 v = *(const f32x2*)(pp->in[5] + l * MODW + nb * 128 + 2 * cl);
#pragma unroll
            for (int w = 0; w < 8; ++w) v += part2[(w * 5 + s) * 64 + cl];
            *(f32x2*)(MOD + ((size_t)l * 5 + s) * MODW + nb * 128 + 2 * cl) = v; }
        __syncthreads();
    }
    if (blockIdx.x == 0) {
        float* rc = (float*)(pp->ws + WS_ROPE); float* rs = rc + 1024;
        for (int i = tid; i < 1024; i += NTHR) { const int pos = i >> 4, f = i & 15;
            const float inv = exp2f(-(float)f * (13.287712379549449f / 16.0f));
            const float a = (float)pos * inv;
            const float kq = rintf(a * 0.15915494309189535f);
            float rr = fmaf(-kq, 6.2831854820251465f, a); rr = fmaf(-kq, -1.7484556000744883e-7f, rr);
            rc[i] = __cosf(rr); rs[i] = __sinf(rr); }
    }
    if (blockIdx.x == 1 && wave == 0) {
        float* LAM = (float*)(pp->ws + WS_LAM);
        for (int l = 0; l < 2; ++l) { const float* lp = pp->in[19] + l * 256;
            const float sa = wave_sum(lp[lane] * lp[64 + lane]), sb = wave_sum(lp[128 + lane] * lp[192 + lane]);
            int lo = l; float c08 = 0.8f, c06 = 0.6f, c1 = 1.0f; asm volatile("" : "+v"(lo), "+v"(c08), "+v"(c06), "+v"(c1)); const float lam_init = c08 - c06 * expf(-0.3f * (float)lo);
            if (lane == 0) { LAM[l * 2 + 0] = expf(sa) - expf(sb) + lam_init; asm volatile("" ::: "memory"); LAM[l * 2 + 1] = c1 - lam_init; } }
    }
}

__device__ __forceinline__ void norm_phase(KP pp, int l, int which, int lane, int gw, int NGW) {
    const int nrows = (l == 1 && which == 2) ? NX : MT;
    const bool first = (l == 0 && which == 0);
    const float* xs = first ? pp->in[0] : pp->out;
    const float* cs = (l == 0 && which <= 1) ? pp->in[2] : (const float*)(pp->ws + WS_CTX);
    const float* pgate = (const float*)(pp->ws + WS_MOD) + (size_t)((which == 0 ? l - 1 : l) * 5 + 4) * MODW + (which == 1 ? 2 : (which == 2 ? 5 : 8)) * 1024;
    const float pscale = (which == 2) ? 1.0f : 0.5f;
    const float* g = pp->in[6] + (l * 3 + which) * 1024; const float* MOD = (const float*)(pp->ws + WS_MOD) + (size_t)l * 5 * MODW;
    bf16* HN = (bf16*)(pp->ws + WS_HN);
    f32x4 gv[4];
#pragma unroll
    for (int j = 0; j < 4; ++j) gv[j] = *(const f32x4*)(g + 4 * lane + 256 * j);
    for (int blk = gw; blk * 8 < NX; blk += NGW) {
        const int r0 = blk * 8; const int set = r0 >> 12;
        const float* sh = MOD + (size_t)set * MODW + (3 * which) * 1024; const float* scl = sh + 1024;
        f32x4 gs[4], sv[4], cur[4], nxt[4];
#pragma unroll
        for (int j = 0; j < 4; ++j) { sv[j] = *(const f32x4*)(sh + 4 * lane + 256 * j); gs[j] = gv[j] * (*(const f32x4*)(scl + 4 * lane + 256 * j) + 1.0f); }
#pragma unroll
        for (int j = 0; j < 4; ++j) cur[j] = *(const f32x4*)(xs + (size_t)r0 * 1024 + 4 * lane + 256 * j);
#pragma unroll
        for (int i = 0; i < 8; ++i) {
            if (i < 7) {
#pragma unroll
                for (int j = 0; j < 4; ++j) nxt[j] = *(const f32x4*)(xs + (size_t)(r0 + i + 1) * 1024 + 4 * lane + 256 * j); }
            float s2 = 0.f;
#pragma unroll
            for (int j = 0; j < 4; ++j) s2 += (cur[j].x * cur[j].x + cur[j].y * cur[j].y) + (cur[j].z * cur[j].z + cur[j].w * cur[j].w);
            const float rstd = 1.0f / sqrtf(wave_sum(s2) * (1.0f / 1024.0f) + EPS);
#pragma unroll
            for (int j = 0; j < 4; ++j) { const f32x4 y = (cur[j] * rstd) * gs[j] + sv[j];
                u32x2 w; w.x = cvt_pk_bf16(y.x, y.y); w.y = cvt_pk_bf16(y.z, y.w);
                *(u32x2*)(HN + (size_t)(r0 + i) * 1024 + 4 * lane + 256 * j) = w; }
#pragma unroll
            for (int j = 0; j < 4; ++j) cur[j] = nxt[j];
        }
    }
    for (int r = NX + (NGW - 1 - gw); r < nrows; r += NGW) {
        const int set = 4;
        const float* xr = cs + (size_t)(r - NX) * 1024;
        const float* sh = MOD + (size_t)set * MODW + (3 * which) * 1024; const float* scl = sh + 1024;
        f32x4 v[4]; float s2 = 0.f;
#pragma unroll
        for (int j = 0; j < 4; ++j) v[j] = *(const f32x4*)(xr + 4 * lane + 256 * j);
        if (!first) {
            const float* PT = (const float*)(pp->ws + WS_PART) + (size_t)(r - NX) * 1024; float* cw = (float*)(pp->ws + WS_CTX) + (size_t)(r - NX) * 1024;
#pragma unroll
            for (int j = 0; j < 4; ++j) { const int o = 4 * lane + 256 * j;
                f32x4 ps = (*(const f32x4*)(PT + o) + *(const f32x4*)(PT + 1048576 + o)) + (*(const f32x4*)(PT + 2097152 + o) + *(const f32x4*)(PT + 3145728 + o));
                ps = ps + ((*(const f32x4*)(PT + 4194304 + o) + *(const f32x4*)(PT + 5242880 + o)) + (*(const f32x4*)(PT + 6291456 + o) + *(const f32x4*)(PT + 7340032 + o)));
                v[j] = v[j] + *(const f32x4*)(pgate + o) * pscale * ps; *(f32x4*)(cw + o) = v[j]; }
        }
#pragma unroll
        for (int j = 0; j < 4; ++j) s2 += (v[j].x * v[j].x + v[j].y * v[j].y) + (v[j].z * v[j].z + v[j].w * v[j].w);
        const float rstd = 1.0f / sqrtf(wave_sum(s2) * (1.0f / 1024.0f) + EPS);
#pragma unroll
        for (int j = 0; j < 4; ++j) { const f32x4 s = *(const f32x4*)(sh + 4 * lane + 256 * j), cc = *(const f32x4*)(scl + 4 * lane + 256 * j);
            const f32x4 y = (v[j] * rstd) * gv[j] * (cc + 1.0f) + s;
            u32x2 w; w.x = cvt_pk_bf16(y.x, y.y); w.y = cvt_pk_bf16(y.z, y.w);
            *(u32x2*)(HN + (size_t)r * 1024 + 4 * lane + 256 * j) = w; }
    }
}
__device__ __forceinline__ void final_norm(KP pp, int lane, int gw, int NGW) {
    const float* g = pp->in[28];
    f32x4 gg[4];
#pragma unroll
    for (int j = 0; j < 4; ++j) gg[j] = *(const f32x4*)(g + 4 * lane + 256 * j);
    for (int blk = gw; blk * 8 < NX; blk += NGW) { float* x0 = pp->out + (size_t)blk * 8 * 1024;
        f32x4 cur[4], nxt[4];
#pragma unroll
        for (int j = 0; j < 4; ++j) cur[j] = *(const f32x4*)(x0 + 4 * lane + 256 * j);
#pragma unroll
        for (int i = 0; i < 8; ++i) {
            if (i < 7) {
#pragma unroll
                for (int j = 0; j < 4; ++j) nxt[j] = *(const f32x4*)(x0 + (size_t)(i + 1) * 1024 + 4 * lane + 256 * j); }
            float s2 = 0.f;
#pragma unroll
            for (int j = 0; j < 4; ++j) s2 += (cur[j].x * cur[j].x + cur[j].y * cur[j].y) + (cur[j].z * cur[j].z + cur[j].w * cur[j].w);
            const float rstd = 1.0f / sqrtf(wave_sum(s2) * (1.0f / 1024.0f) + EPS);
#pragma unroll
            for (int j = 0; j < 4; ++j) *(f32x4*)(x0 + (size_t)i * 1024 + 4 * lane + 256 * j) = (cur[j] * rstd) * gg[j];
#pragma unroll
            for (int j = 0; j < 4; ++j) cur[j] = nxt[j];
        }
    }
}

__device__ __forceinline__ void unpack8(const u32x4 w, float* f) { f[0] = bf_lo(w.x); f[1] = bf_hi(w.x); f[2] = bf_lo(w.y); f[3] = bf_hi(w.y); f[4] = bf_lo(w.z); f[5] = bf_hi(w.z); f[6] = bf_lo(w.w); f[7] = bf_hi(w.w); }
__device__ __forceinline__ u32x4 pack8(const float* f) { u32x4 w; w.x = cvt_pk_bf16(f[0], f[1]); w.y = cvt_pk_bf16(f[2], f[3]); w.z = cvt_pk_bf16(f[4], f[5]); w.w = cvt_pk_bf16(f[6], f[7]); return w; }
__device__ __forceinline__ void batch_bounds(int r, int& b0, int& b1) { if (r < NX) { b0 = r & ~(SEQ - 1); b1 = b0 + SEQ; } else { b0 = NX + ((r - NX) & ~(CTXL - 1)); b1 = b0 + CTXL; } }

__device__ __forceinline__ void branch_a(KP pp, int l, int nrows, int gtid, int ngt) {
    bf16* PX = (bf16*)(pp->ws + WS_PX); const float* cw = pp->in[14] + l * 768;
    for (int it = gtid; it < nrows * 32; it += ngt) {
        const int r = it >> 5, c0 = (it & 31) * 8; int b0, b1; batch_bounds(r, b0, b1);
        float acc[8];
#pragma unroll
        for (int i = 0; i < 8; ++i) acc[i] = 0.f;
#pragma unroll
        for (int k = 0; k < 3; ++k) { const int rr = r + k - 1;
            if (rr >= b0 && rr < b1) { float cg[8], xi[8]; unpack8(*(const u32x4*)(PX + (size_t)rr * PXW + 256 + c0), cg); unpack8(*(const u32x4*)(PX + (size_t)rr * PXW + 512 + c0), xi);
                const f32x4 w0 = *(const f32x4*)(cw + k * 256 + c0), w1 = *(const f32x4*)(cw + k * 256 + c0 + 4);
                acc[0] += w0.x * cg[0] * xi[0]; acc[1] += w0.y * cg[1] * xi[1]; acc[2] += w0.z * cg[2] * xi[2]; acc[3] += w0.w * cg[3] * xi[3];
                acc[4] += w1.x * cg[4] * xi[4]; acc[5] += w1.y * cg[5] * xi[5]; acc[6] += w1.z * cg[6] * xi[6]; acc[7] += w1.w * cg[7] * xi[7]; } }
        float bg[8]; unpack8(*(const u32x4*)(PX + (size_t)r * PXW + c0), bg);
#pragma unroll
        for (int i = 0; i < 8; ++i) acc[i] *= bg[i];
        *(u32x4*)(PX + (size_t)r * PXW + c0) = pack8(acc);
    }
}

__device__ __forceinline__ void branch_b(KP pp, int l, int nrows, unsigned char* lds_g, int tid, int vcu, int G) {
    bf16* PX = (bf16*)(pp->ws + WS_PX); LAS unsigned short* vt = (LAS unsigned short*)lds_g;
    const int lane = tid & 63, wave = tid >> 6, quad = lane >> 4, l15 = lane & 15;
    const int nunits = (nrows / 128) * 4;
    for (int ut = G - 1 - vcu; ut < nunits; ut += G) {
        const int ch = ut >> 2, g = ut & 3; const int q = tid >> 2, part = tid & 3;
        const bf16* vr = PX + (size_t)(ch * 128 + q) * PXW + 1024;
        float s1 = 0.f, s2 = 0.f;
#pragma unroll
        for (int j = 0; j < 8; ++j) { float f[8]; unpack8(*(const u32x4*)(vr + part * 64 + j * 8), f);
#pragma unroll
            for (int i = 0; i < 8; ++i) { s1 += f[i]; s2 += f[i] * f[i]; } }
        s1 += __shfl_xor(s1, 1); s1 += __shfl_xor(s1, 2); s2 += __shfl_xor(s2, 1); s2 += __shfl_xor(s2, 2);
        const float mean = s1 * (1.0f / 256.0f); const float var = fmaxf(s2 * (1.0f / 256.0f) - mean * mean, 0.f); const float rstd = 1.0f / sqrtf(var + EPS);
#pragma unroll
        for (int j = 0; j < 2; ++j) { float f[8]; unpack8(*(const u32x4*)(vr + g * 64 + part * 16 + j * 8), f);
#pragma unroll
            for (int i = 0; i < 8; i += 2) { const unsigned w = cvt_pk_bf16((f[i] - mean) * rstd, (f[i + 1] - mean) * rstd);
                vt[(part * 16 + j * 8 + i) * 136 + q] = (unsigned short)(w & 0xffffu); vt[(part * 16 + j * 8 + i + 1) * 136 + q] = (unsigned short)(w >> 16); } }
        __syncthreads();
        f32x4 acc[4];
#pragma unroll
        for (int nt = 0; nt < 4; ++nt) acc[nt] = (f32x4){0.f, 0.f, 0.f, 0.f};
        const float* wrow = pp->in[16] + ((size_t)(l * 4 + g) * 128 + 16 * wave + l15) * 128 + 8 * quad;
#pragma unroll
        for (int ks = 0; ks < 4; ++ks) {
            const f32x4 w0 = *(const f32x4*)(wrow + 32 * ks), w1 = *(const f32x4*)(wrow + 32 * ks + 4);
            u32x4 aw; aw.x = cvt_pk_bf16(w0.x, w0.y); aw.y = cvt_pk_bf16(w0.z, w0.w); aw.z = cvt_pk_bf16(w1.x, w1.y); aw.w = cvt_pk_bf16(w1.z, w1.w);
            const pg8::bf16x8 a = __builtin_bit_cast(pg8::bf16x8, aw);
#pragma unroll
            for (int nt = 0; nt < 4; ++nt) { const pg8::bf16x8 b = *(const LAS pg8::bf16x8*)(vt + (16 * nt + l15) * 136 + 32 * ks + 8 * quad);
                acc[nt] = __builtin_amdgcn_mfma_f32_16x16x32_bf16(a, b, acc[nt], 0, 0, 0); }
        }
#pragma unroll
        for (int i = 0; i < 4; ++i) { const int p = 16 * wave + quad * 4 + i; const float bias = pp->in[17][(l * 4 + g) * 128 + p];
            bf16* up = PX + (size_t)(ch * 128 + p) * PXW + 768 + g * 64 + l15;
#pragma unroll
            for (int nt = 0; nt < 4; ++nt) { const float uv = __uint_as_float((unsigned)up[16 * nt] << 16); up[16 * nt] = (bf16)(cvt_pk_bf16(uv * (acc[nt][i] + bias), 0.f) & 0xffffu); } }
        __syncthreads();
    }
}

__device__ __forceinline__ void branch_d(KP pp, int l, int nrows, unsigned char* lds_g, int tid, int lane, int wave, int vcu, int G) {
    const bf16* PX = (const bf16*)(pp->ws + WS_PX); bf16* AD = (bf16*)(pp->ws + WS_ACTD);
    LAS float* hs = (LAS float*)lds_g;
    LAS float* cv = (LAS float*)(lds_g + 65536);
    const float* dw = pp->in[22] + l * 31 * 256; const float* db = pp->in[23] + l * 256; const float* lg = pp->in[24] + l * 256; const float* lb = pp->in[25] + l * 256;
    const int nunits = nrows / 32;
    for (int ut = G - 1 - vcu; ut < nunits; ut += G) {
        const int R0 = ut * 32; int b0, b1; batch_bounds(R0, b0, b1);
        for (int it = tid; it < 62 * 32; it += NTHR) { const int rr = it >> 5, c0 = (it & 31) * 8; const int r = R0 - 15 + rr;
            float h[8];
            if (r >= b0 && r < b1) { float z0[8], z1[8]; unpack8(*(const u32x4*)(PX + (size_t)r * PXW + D_OFF + c0), z0); unpack8(*(const u32x4*)(PX + (size_t)r * PXW + D_OFF + 256 + c0), z1);
#pragma unroll
                for (int i = 0; i < 8; ++i) h[i] = z0[i] * fsigmoid(z1[i]); }
            else {
#pragma unroll
                for (int i = 0; i < 8; ++i) h[i] = 0.f; }
            *(LAS f32x4*)(hs + rr * 256 + c0) = (f32x4){h[0], h[1], h[2], h[3]}; *(LAS f32x4*)(hs + rr * 256 + c0 + 4) = (f32x4){h[4], h[5], h[6], h[7]}; }
        __syncthreads();
        { const int c = tid & 255, half = tid >> 8; const float bias = db[c];
            float o[16];
#pragma unroll
            for (int i = 0; i < 16; ++i) o[i] = bias;
#pragma unroll
            for (int k = 0; k < 31; ++k) { const float w = dw[k * 256 + c];
#pragma unroll
                for (int i = 0; i < 16; ++i) o[i] += w * hs[(half * 16 + i + k) * 256 + c]; }
#pragma unroll
            for (int i = 0; i < 16; ++i) cv[(half * 16 + i) * 256 + c] = o[i]; }
        __syncthreads();
#pragma unroll
        for (int i = 0; i < 4; ++i) { const int rr = wave * 4 + i; const f32x4 v = *(const LAS f32x4*)(cv + rr * 256 + 4 * lane);
            const float mean = wave_sum((v.x + v.y) + (v.z + v.w)) * (1.0f / 256.0f); const f32x4 d = v - mean;
            const float var = wave_sum((d.x * d.x + d.y * d.y) + (d.z * d.z + d.w * d.w)) * (1.0f / 256.0f); const float rstd = 1.0f / sqrtf(var + EPS);
            const f32x4 gg = *(const f32x4*)(lg + 4 * lane), bb = *(const f32x4*)(lb + 4 * lane); const f32x4 y = d * rstd * gg + bb;
            u32x2 w; w.x = cvt_pk_bf16(fsilu(y.x), fsilu(y.y)); w.y = cvt_pk_bf16(fsilu(y.z), fsilu(y.w));
            *(u32x2*)(AD + (size_t)(R0 + rr) * 256 + 4 * lane) = w; }
        __syncthreads();
    }
}

__device__ __forceinline__ void act_c(KP pp, int l, int r0, int h, int tid) {
    const bf16* OB = (const bf16*)(pp->ws + WS_OB); bf16* PX = (bf16*)(pp->ws + WS_PX); const float* LAM = (const float*)(pp->ws + WS_LAM) + l * 2;
    const float lam = LAM[0], oml = LAM[1]; const float* sg = pp->in[20] + l * 128;
    const int sub = tid & 15; f32x4 g0 = *(const f32x4*)(sg + sub * 8), g1 = *(const f32x4*)(sg + sub * 8 + 4);
#pragma unroll
    for (int it = 0; it < 8; ++it) { const int r = r0 + it * 32 + (tid >> 4);
        float a[8], b[8], o[8]; unpack8(*(const u32x4*)(OB + (size_t)r * 1024 + h * 256 + sub * 8), a); unpack8(*(const u32x4*)(OB + (size_t)r * 1024 + h * 256 + 128 + sub * 8), b);
        float s2 = 0.f;
#pragma unroll
        for (int i = 0; i < 8; ++i) { o[i] = a[i] - lam * b[i]; s2 += o[i] * o[i]; }
        s2 += __shfl_xor(s2, 1); s2 += __shfl_xor(s2, 2); s2 += __shfl_xor(s2, 4); s2 += __shfl_xor(s2, 8);
        const float rs = oml / sqrtf(s2 * (1.0f / 128.0f) + EPS);
        o[0] *= rs * g0.x; o[1] *= rs * g0.y; o[2] *= rs * g0.z; o[3] *= rs * g0.w; o[4] *= rs * g1.x; o[5] *= rs * g1.y; o[6] *= rs * g1.z; o[7] *= rs * g1.w;
        *(u32x4*)(PX + (size_t)r * PXW + Q_OFF + h * 128 + sub * 8) = pack8(o); }
}

__device__ __forceinline__ void attn_mix_phase(KP pp, int l, unsigned char* lds_g, int tid, int lane, int wave, int vcu, int G) {
    using abf = attn_body::bf16;
    const abf* PX = (const abf*)(pp->ws + WS_PX); abf* OB = (abf*)(pp->ws + WS_OB);
    const int njobs = 256 + ((l == 0) ? 16 : 0);
    for (int j = vcu; j < njobs; j += G) {
        int b, h, r0, krow0, ntm, krow1, NT;
        if (j < 256) { const int bh = j >> 4, qb = j & 15; b = bh >> 2; h = bh & 3; r0 = b * SEQ + qb * 256; krow0 = b * SEQ; ntm = 64; krow1 = NX + b * CTXL; NT = 68; }
        else { const int w = j - 256; b = w >> 2; h = w & 3; r0 = NX + b * CTXL; krow0 = r0; ntm = 4; krow1 = r0; NT = 4; }
#pragma unroll 1
        for (int me_ = 0; me_ < 2 * MK_REP_ATTN; ++me_) { const int m = me_ & 1;
            attn_body::attn_unit2<8>(PX + (size_t)r0 * PXW + Q_OFF + h * 128 + m * 64, PX + K_OFF + h * 128 + m * 64, PX + V_OFF + h * 128,
                                     OB + (size_t)r0 * 1024 + h * 256 + m * 128, krow0, ntm, krow1, NT, (char*)lds_g); }
        __threadfence(); __syncthreads(); __builtin_amdgcn_fence(__ATOMIC_ACQUIRE, "agent");
        act_c(pp, l, r0, h, tid);
        __syncthreads();
    }
    const int nrows = (l == 0) ? MT : NX;
    branch_a(pp, l, nrows, vcu * NTHR + tid, G * NTHR);
    branch_b(pp, l, nrows, lds_g, tid, vcu, G);
    branch_d(pp, l, nrows, lds_g, tid, lane, wave, vcu, G);
}

__global__ void __launch_bounds__(NTHR, 2) mega_fwd(Params p) {
    extern __shared__ __attribute__((aligned(16))) unsigned char lds[];
    cg::grid_group grid = cg::this_grid();
    KP pk = (KP)__builtin_amdgcn_kernarg_segment_ptr();
    const int ph_lo = pk->ph_lo, ph_hi = pk->ph_hi;
    volatile LAS unsigned* bst = (volatile LAS unsigned*)((LAS unsigned char*)lds + 131072 + 64);
    if (threadIdx.x < 2) bst[threadIdx.x] = 0u;
    __syncthreads();
    XcdBarrier xbar = xcd_barrier_post((unsigned*)(pk->ws + WS_BAR), bst);
    for (int pi = ph_lo; pi < ph_hi; ++pi) {
        const int ph = (MK_REP_PH >= 0 && pi > MK_REP_PH) ? pi - 1 : pi;
        KP pp = pk; asm volatile("" : "+s"(pp));
        const int tid = tid_now(), lane = tid & 63, wave = __builtin_amdgcn_readfirstlane(tid >> 6);
        const int G = gridDim.x; int bx = blockIdx.x; asm volatile("" : "+s"(bx)); const int vcu = (G % 8 == 0) ? (bx % 8) * (G / 8) + bx / 8 : bx;
        const int gw = vcu * NWAVES + wave, NGW = G * NWAVES;
        pg8::LdsPtr ldsp = (pg8::LdsPtr)lds;
        if (ph == 0) prologue(pp, lds, tid, lane, wave, vcu, G);
        else if (ph == 23) final_norm(pp, lane, gw, NGW);
        else {
            const int l = (ph - 1) / 11, s = (ph - 1) % 11;
            bf16* HN = (bf16*)(pp->ws + WS_HN); bf16* PX = (bf16*)(pp->ws + WS_PX); bf16* MG = (bf16*)(pp->ws + WS_OB);
            const bf16* WB = (const bf16*)(pp->ws + WS_W) + (size_t)l * LW_TOTAL;
            if (s == 0 || s == 3 || s == 8) norm_phase(pp, l, s == 0 ? 0 : (s == 3 ? 1 : 2), lane, gw, NGW);
            else if (s == 1 || s == 9) {
                const int Mrows = (l == 1 && s == 9) ? NX : MT;
                pg8::Gemm g{HN, WB + (s == 1 ? LW_UP1 : LW_UP2), 1024, 1024, 1024}; pg8::StaticOrder S; S.init(Mrows, 5632, G, bx);
                pg8::EpiSwiGLU E{PX};
                pg8::gemm_phase<pg8::EpiSwiGLU, pg8::StaticOrder, true, true>(ldsp, g, S, E);
            } else if (s == 2 || s == 7 || s == 10) {
                const bool first = (l == 0 && s == 2); const bool ctxrows = !(l == 1 && s != 2);
                float* CTX = (float*)(pp->ws + WS_CTX); const float* MOD = (const float*)(pp->ws + WS_MOD) + (size_t)l * 5 * MODW;
                const bf16* A = (s == 7) ? MG : PX; const int lda = (s == 7) ? 1024 : FF; const int K = lda;
                const bf16* W = WB + (s == 2 ? LW_DN1 : (s == 7 ? LW_O : LW_DN2));
                { pg8::Gemm g{A, W, lda, K, K}; pg8::StaticOrder S; S.init(NX, 1024, G, bx);
                  pg8::EpiRes E{first ? pp->in[0] : pp->out, CTX, pp->out, CTX, MOD + (s == 2 ? 2 : (s == 7 ? 5 : 8)) * 1024, (s == 7) ? 1.0f : 0.5f};
                  pg8::gemm_phase<pg8::EpiRes, pg8::StaticOrder, true, true>(ldsp, g, S, E); }
                if (ctxrows && (bx & 1) == 1) {
                    KP pq = pk; asm volatile("" : "+s"(pq));
                    const int j = bx >> 1, ut = j >> 3, sp = j & 7;
                    pg8::OneUnit S1{pg8::Unit{64 + (ut >> 2), ut & 3}};
                    const bf16* WB2 = (const bf16*)(pq->ws + WS_W) + (size_t)l * LW_TOTAL; float* PT = (float*)(pq->ws + WS_PART) + (size_t)sp * 1048576;
                    const bf16* A2; const bf16* W2; int ld2, kc;
                    if (s == 7) { const int kh = (sp & 1) * 512;
                        A2 = (const bf16*)(pq->ws + WS_MGP) + (size_t)(sp >> 1) * 1048576 - (size_t)NX * 1024 + kh; W2 = WB2 + LW_O + kh; ld2 = 1024; kc = 512;
                    } else { const int k0 = (sp < 6) ? sp * 384 : 2304 + (sp - 6) * 256;
                        A2 = (const bf16*)(pq->ws + WS_PX) + k0; W2 = WB2 + (s == 2 ? LW_DN1 : LW_DN2) + k0; ld2 = FF; kc = (sp < 6) ? 384 : 256; }
                    pg8::Gemm g{A2, W2, ld2, ld2, kc}; pg8::EpiPart E{PT};
                    pg8::gemm_phase<pg8::EpiPart, pg8::OneUnit, true, true>(ldsp, g, S1, E);
                }
            } else if (s == 4) {
                pg8::Gemm g{HN, WB + LW_WIN, 1024, 1024, 1024}; pg8::StaticOrder S; S.init(MT, PXW, G, bx);
                pg8::EpiWin E{PX, (const float*)(pp->ws + WS_ROPE), (const float*)(pp->ws + WS_ROPE) + 1024, C2};
                pg8::gemm_phase<pg8::EpiWin, pg8::StaticOrder, true, true>(ldsp, g, S, E);
            } else if (s == 5) attn_mix_phase(pp, l, lds, tid, lane, wave, vcu, G);
            else if (s == 6) {
                const int nctx = (l == 0 && (bx & 3) == 1) ? 1 : 0;
                pg8::StaticOrder S; S.init(NX, 1024, G, bx); pg8::Unit u;
                for (int i = 0; i < 1 + nctx; ++i) {
                    int br_lo = 0, br_hi = 4;
                    if (i == 0) { if (!S.next(0, u)) continue; }
                    else { const int j = bx >> 2, ut = j >> 2; u.pm = 64 + (ut >> 2); u.pn = ut & 3; br_lo = j & 3; br_hi = br_lo + 1; }
#pragma unroll 1
                    for (int br = br_lo; br < br_hi; ++br) {
                        if (!((MK_BRMASK >> br) & 1)) continue;
                        KP pq = pk; asm volatile("" : "+s"(pq));
                        bf16* GSw = (bf16*)(pq->ws + WS_GS) + (size_t)bx * 65536; const bf16* HN2 = (const bf16*)(pq->ws + WS_HN);
                        const bf16* WB2 = (const bf16*)(pq->ws + WS_W) + (size_t)l * LW_TOTAL;
                        pg8::OneUnit S1{u};
                        { pg8::Gemm g{HN2, WB2 + LW_WIN + (size_t)(G_OFF + br * 1024) * 1024, 1024, 1024, 1024}; pg8::EpiGate E{GSw};
                          pg8::gemm_phase<pg8::EpiGate, pg8::OneUnit, true, true>(ldsp, g, S1, E); }
                        const bf16* PX2 = (const bf16*)(pq->ws + WS_PX);
                        const bf16* A = (br == 0) ? PX2 + A_OFF : (br == 1) ? PX2 + B_OFF : (br == 2) ? PX2 + Q_OFF : (const bf16*)(pq->ws + WS_ACTD);
                        const int lda = (br == 3) ? 256 : PXW; const int K = (br == 2) ? 512 : 256;
                        const bf16* W = WB2 + ((br == 0) ? LW_AO : (br == 1) ? LW_BO : (br == 2) ? LW_CO : LW_DO);
                        bf16* MGd = (i == 0) ? (bf16*)(pq->ws + WS_OB) : (bf16*)(pq->ws + WS_MGP) + (size_t)br * 1048576 - (size_t)NX * 1024;
                        { pg8::Gemm g{A, W, lda, K, K}; pg8::EpiBranch E{GSw, MGd, (i == 0) ? ((MK_BRMASK & ((1 << br) - 1)) == 0) : 1};
                          pg8::gemm_phase<pg8::EpiBranch, pg8::OneUnit, true, true>(ldsp, g, S1, E); }
                    }
                }
                if (l == 0 && (bx & 3) != 1) {
                    KP pq = pk; asm volatile("" : "+s"(pq));
                    convert_weights(pq, lds, 1, (bx - ((bx + 2) >> 2)) * NWAVES + wave, (G - G / 4) * NWAVES, lane, wave);
                }
            }
        }
        if (pi + 1 < ph_hi) {
            if (ph_hi > 4096) grid.sync();
            xcd_barrier(xbar);
        }
    }
}


extern "C" void kernel_launch(void* const* d_in, const int* in_sizes, int n_in, void* d_out, int out_size, void* d_ws, size_t ws_size, hipStream_t stream) {
    static int grid = 0;
    if (grid == 0) {
        if (n_in != 29 || out_size != NX * 1024 || ws_size < WS_END) { fprintf(stderr, "kernel_launch: unexpected shapes / workspace (n_in %d out %d ws %zu)\n", n_in, out_size, ws_size); grid = -1; return; }
        int dev = 0, cus = 0, per_cu = 0;
        if (hipGetDevice(&dev) != hipSuccess || hipDeviceGetAttribute(&cus, hipDeviceAttributeMultiprocessorCount, dev) != hipSuccess) { grid = -1; return; }
        if (hipFuncSetAttribute((const void*)mega_fwd, hipFuncAttributeMaxDynamicSharedMemorySize, LDS_BYTES) != hipSuccess) { fprintf(stderr, "kernel_launch: hipFuncSetAttribute failed\n"); grid = -1; return; }
        if (hipOccupancyMaxActiveBlocksPerMultiprocessor(&per_cu, (const void*)mega_fwd, NTHR, LDS_BYTES) != hipSuccess || per_cu < 1) { fprintf(stderr, "kernel_launch: occupancy query says %d\n", per_cu); per_cu = 1; }
        (void)hipGetLastError();
        grid = cus;
    }
    if (grid < 0) return;
    if (hipMemsetAsync((char*)d_ws + WS_BAR, 0, 16384, stream) != hipSuccess) { fprintf(stderr, "kernel_launch: memset failed\n"); return; }
    Params p{};
    for (int i = 0; i < 29; ++i) p.in[i] = (const float*)d_in[i];
    p.out = (float*)d_out; p.ws = (unsigned char*)d_ws;
#if MK_PER_PHASE
    for (int ph = 0; ph < 24; ++ph) { if (ph >= MK_NPH && ph != 23) continue; p.ph_lo = ph; p.ph_hi = ph + 1; hipLaunchKernelGGL(mega_fwd, dim3(grid), dim3(NTHR), LDS_BYTES, stream, p); }
#else
    p.ph_lo = 0; p.ph_hi = 24 + ((MK_REP_PH >= 0) ? 1 : 0);
    void* args[] = {&p};
    hipError_t e = hipLaunchCooperativeKernel((const void*)mega_fwd, dim3(grid), dim3(NTHR), args, LDS_BYTES, stream);
    if (e != hipSuccess) fprintf(stderr, "cooperative launch failed: %s (grid %d)\n", hipGetErrorString(e), grid);
#endif
}
```

```cpp
#include <hip/hip_runtime.h>
#include <hip/hip_cooperative_groups.h>
#include <hip/hip_bf16.h>
#include <cstdio>
#include <cstdint>
#include <cmath>
namespace cg = cooperative_groups;
__device__ __forceinline__ int tid_now() { int t = threadIdx.x; asm volatile("" : "+v"(t)); return t; }
#ifndef MK_PER_PHASE
#define MK_PER_PHASE 0
#endif
#ifndef MK_NPH
#define MK_NPH 24
#endif
#ifndef MK_BRMASK
#define MK_BRMASK 15
#endif
#ifndef MK_REP_PH
#define MK_REP_PH -1
#endif
#ifndef MK_REP_ATTN
#define MK_REP_ATTN 1
#endif
namespace pg8 {
#define PG8_LAS __attribute__((address_space(3)))
typedef unsigned short bf16_t;
typedef short bf16x8 __attribute__((ext_vector_type(8)));
typedef float f32x4 __attribute__((ext_vector_type(4)));
typedef unsigned u32x4 __attribute__((ext_vector_type(4)));
typedef PG8_LAS unsigned char* LdsPtr;
constexpr int BM = 256, BK = 64, HALF = 128, HTB = HALF * BK * 2  , STAGE_BYTES = 8 * HTB, NXCD = 8, WGM = 8;

__host__ __device__ __forceinline__ int lds_byte(int r, int c) { const int st = (r >> 4) * 2 + (c >> 5), rr = r & 15, cc = c & 31, ob = rr * 64 + cc * 2; return st * 1024 + (ob ^ (((ob >> 9) & 1) << 5)); }
__host__ __device__ __forceinline__ void stage_rc(int b, int& R, int& C) { const int st = b / 1024, sb = b % 1024, swz = sb ^ (((sb >> 9) & 1) << 5); R = (st >> 1) * 16 + swz / 64; C = (st & 1) * 32 + (swz % 64) / 2; }
__host__ __device__ __forceinline__ int perm32(int rho) { const int n = rho >> 4, i = rho & 15; return 8 * (i >> 2) + 4 * n + (i & 3); }

struct Unit { int pm, pn; };
struct Gemm { const bf16_t* A; const bf16_t* Bt; int lda, ldb, K; };

struct StaticOrder {
    int nM, nN, nwg, G, c;
    __host__ __device__ void init(int M, int N, int G_, int c_) { nM = M / BM; nN = N / BM; nwg = nM * nN; G = G_; c = c_; }
    __host__ __device__ bool next(int i, Unit& u) const {
        const long L = (long)i * G + c; if (L >= nwg) return false;
        int wgid = (int)L; { const int q = nwg / NXCD, r = nwg % NXCD, xcd = wgid % NXCD, off = wgid / NXCD; wgid = (xcd < r ? xcd * (q + 1) : r * (q + 1) + (xcd - r) * q) + off; }
        const int nig = WGM * nN, gid = wgid / nig, fm = gid * WGM, gsz = (nM - fm) < WGM ? (nM - fm) : WGM;
        u.pm = fm + ((wgid % nig) % gsz); u.pn = (wgid % nig) / gsz; return true;
    }
    __device__ __forceinline__ void a_ready(const Unit&) const {}
    __device__ __forceinline__ void done(const Unit&) const {}
};


struct OneUnit {
    Unit u;
    __device__ __forceinline__ bool next(int i, Unit& o) const { if (i) return false; o = u; return true; }
    __device__ __forceinline__ void a_ready(const Unit&) const {}
    __device__ __forceinline__ void done(const Unit&) const {}
};

typedef float f32x2_cv __attribute__((ext_vector_type(2))); typedef __bf16 bf16x2_cv __attribute__((ext_vector_type(2)));
__device__ __forceinline__ unsigned cvt_pk_bf16(float lo, float hi) { f32x2_cv v = {lo, hi}; bf16x2_cv b = __builtin_convertvector(v, bf16x2_cv); return __builtin_bit_cast(unsigned, b); }
typedef unsigned u32x2 __attribute__((ext_vector_type(2)));
__device__ __forceinline__ float fsigmoid(float v) { return __builtin_amdgcn_rcpf(1.0f + __builtin_amdgcn_exp2f(-1.4426950408889634f * v)); }
__device__ __forceinline__ float fsilu(float v) { return v * fsigmoid(v); }
__device__ __forceinline__ float ftanh(float v) { return 2.0f * fsigmoid(2.0f * v) - 1.0f; }
__device__ __forceinline__ float fgelu_tanh(float v) { const float u = 0.7978845608028654f * (v + 0.044715f * v * v * v); return v * fsigmoid(2.0f * u); }
__device__ __forceinline__ float bf_lo(unsigned w) { return __uint_as_float(w << 16); }
__device__ __forceinline__ float bf_hi(unsigned w) { return __uint_as_float(w & 0xffff0000u); }

constexpr int ROWS_X = 16384, PXW = 3328, DFF = 2816, MODW = 9216;

struct EpiSwiGLU {
    static constexpr bool PERM = true, AFTER_DRAIN = false;
    bf16_t* H;
    __device__ __forceinline__ void operator()(const f32x4 (&acc)[2][2][4][2], const Unit& u, int wr, int wc, int fr, int fq) const {
        const int row0 = u.pm * BM + wr * 64 + fr, col0 = u.pn * HALF + wc * 32 + 8 * fq;
#pragma unroll
        for (int ai = 0; ai < 2; ++ai)
#pragma unroll
            for (int m = 0; m < 4; ++m) {
                bf16_t* rowp = H + (size_t)(row0 + ai * HALF + m * 16) * DFF + col0;
                const f32x4 a0 = acc[ai][0][m][0], a1 = acc[ai][0][m][1], b0 = acc[ai][1][m][0], b1 = acc[ai][1][m][1];
                u32x4 w;
                w.x = cvt_pk_bf16(fsilu(a0[0]) * b0[0], fsilu(a0[1]) * b0[1]); w.y = cvt_pk_bf16(fsilu(a0[2]) * b0[2], fsilu(a0[3]) * b0[3]);
                w.z = cvt_pk_bf16(fsilu(a1[0]) * b1[0], fsilu(a1[1]) * b1[1]); w.w = cvt_pk_bf16(fsilu(a1[2]) * b1[2], fsilu(a1[3]) * b1[3]);
                *(u32x4*)rowp = w;
            }
    }
};

struct EpiRes {
    static constexpr bool PERM = false, AFTER_DRAIN = false;
    const float* bx; const float* bc; float* ox; float* oc; const float* gate; float sc;
    __device__ __forceinline__ void operator()(const f32x4 (&acc)[2][2][4][2], const Unit& u, int wr, int wc, int fr, int fq) const {
        const bool isx = u.pm < 64; const int set = isx ? (u.pm >> 4) : 4;
        const size_t roff = (size_t)(isx ? u.pm : u.pm - 64) * BM * 1024;
        const float* base = (isx ? bx : bc) + roff; float* out = (isx ? ox : oc) + roff;
        const int col0 = u.pn * BM + wc * 32 + 4 * fq; const float* gp = gate + (size_t)set * MODW + col0;
        f32x4 gv[2][2];
#pragma unroll
        for (int bj = 0; bj < 2; ++bj)
#pragma unroll
            for (int n = 0; n < 2; ++n) gv[bj][n] = *(const f32x4*)(gp + bj * HALF + n * 16) * sc;
#pragma unroll
        for (int ai = 0; ai < 2; ++ai)
#pragma unroll
            for (int m = 0; m < 4; ++m) {
                const size_t off = (size_t)(ai * HALF + wr * 64 + m * 16 + fr) * 1024 + col0;
#pragma unroll
                for (int bj = 0; bj < 2; ++bj)
#pragma unroll
                    for (int n = 0; n < 2; ++n) {
                        const f32x4 b = *(const f32x4*)(base + off + bj * HALF + n * 16);
                        *(f32x4*)(out + off + bj * HALF + n * 16) = b + gv[bj][n] * acc[ai][bj][m][n];
                    }
            }
    }
};

__device__ __forceinline__ float lane32_partner(float x, bool hi) { auto rr = __builtin_amdgcn_permlane32_swap(__float_as_uint(x), __float_as_uint(x), false, false); return __uint_as_float(hi ? rr[0] : rr[1]); }
struct EpiWin {
    static constexpr bool PERM = true, AFTER_DRAIN = false;
    bf16_t* PX; const float* rcos; const float* rsin; float qscale;
    __device__ __forceinline__ void operator()(const f32x4 (&acc)[2][2][4][2], const Unit& u, int wr, int wc, int fr, int fq) const {
        const int pn = u.pn; const bool isx = u.pm < 64;
        const bool gel = (pn == 3 || pn == 4), isq = (pn == 5 || pn == 6), rope = (pn >= 5 && pn <= 8) && isx;
        const float sc = isq ? qscale : 1.0f; const bool hi = fq >= 2; const float sgn = hi ? 1.0f : -1.0f;
        const int col0 = pn * BM + wc * 32 + 8 * fq;
#pragma unroll
        for (int ai = 0; ai < 2; ++ai)
#pragma unroll
            for (int m = 0; m < 4; ++m) {
                const int row = u.pm * BM + ai * HALF + wr * 64 + m * 16 + fr;
                bf16_t* rowp = PX + (size_t)row * PXW + col0;
                f32x4 c0 = (f32x4){1.f, 1.f, 1.f, 1.f}, c1 = c0, s0 = (f32x4){0.f, 0.f, 0.f, 0.f}, s1 = s0;
                if (rope) { const int pos = (wc & 1) ? (m * 16 + fr) : ((4 * u.pm + 2 * ai + wr) & 63); const int fo = pos * 16 + 8 * (fq & 1);
                    c0 = *(const f32x4*)(rcos + fo); c1 = *(const f32x4*)(rcos + fo + 4); s0 = *(const f32x4*)(rsin + fo) * sgn; s1 = *(const f32x4*)(rsin + fo + 4) * sgn; }
#pragma unroll
                for (int bj = 0; bj < 2; ++bj) {
                    f32x4 v0 = acc[ai][bj][m][0], v1 = acc[ai][bj][m][1];
                    if (gel) {
#pragma unroll
                        for (int i = 0; i < 4; ++i) { v0[i] = fgelu_tanh(v0[i]); v1[i] = fgelu_tanh(v1[i]); }
                    }
                    if (rope) { f32x4 p0, p1;
#pragma unroll
                        for (int i = 0; i < 4; ++i) { p0[i] = lane32_partner(v0[i], hi); p1[i] = lane32_partner(v1[i], hi); }
                        v0 = v0 * c0 + p0 * s0; v1 = v1 * c1 + p1 * s1; }
                    v0 = v0 * sc; v1 = v1 * sc;
                    u32x4 w; w.x = cvt_pk_bf16(v0[0], v0[1]); w.y = cvt_pk_bf16(v0[2], v0[3]); w.z = cvt_pk_bf16(v1[0], v1[1]); w.w = cvt_pk_bf16(v1[2], v1[3]);
                    *(u32x4*)(rowp + bj * HALF) = w;
                }
            }
    }
};

struct EpiGate {
    static constexpr bool PERM = true, AFTER_DRAIN = false;
    bf16_t* GS;
    __device__ __forceinline__ void operator()(const f32x4 (&acc)[2][2][4][2], const Unit& u, int wr, int wc, int fr, int fq) const {
        const int tid = tid_now();
#pragma unroll
        for (int ai = 0; ai < 2; ++ai)
#pragma unroll
            for (int bj = 0; bj < 2; ++bj)
#pragma unroll
                for (int m = 0; m < 4; ++m) {
                    const f32x4 a0 = acc[ai][bj][m][0], a1 = acc[ai][bj][m][1];
                    u32x4 w; w.x = cvt_pk_bf16(fsigmoid(a0[0]), fsigmoid(a0[1])); w.y = cvt_pk_bf16(fsigmoid(a0[2]), fsigmoid(a0[3]));
                    w.z = cvt_pk_bf16(fsigmoid(a1[0]), fsigmoid(a1[1])); w.w = cvt_pk_bf16(fsigmoid(a1[2]), fsigmoid(a1[3]));
                    *(u32x4*)(GS + ((size_t)(((ai * 2 + bj) * 4 + m) * 512 + tid)) * 8) = w;
                }
    }
};

struct EpiBranch {
    static constexpr bool PERM = true, AFTER_DRAIN = false;
    const bf16_t* GS; bf16_t* MG; int first;
    __device__ __forceinline__ void operator()(const f32x4 (&acc)[2][2][4][2], const Unit& u, int wr, int wc, int fr, int fq) const {
        const int tid = tid_now();
        const int row0 = u.pm * BM + wr * 64 + fr, col0 = u.pn * BM + wc * 32 + 8 * fq;
#pragma unroll
        for (int ai = 0; ai < 2; ++ai)
#pragma unroll
            for (int bj = 0; bj < 2; ++bj)
#pragma unroll
                for (int m = 0; m < 4; ++m) {
                    const u32x4 g = *(const u32x4*)(GS + ((size_t)(((ai * 2 + bj) * 4 + m) * 512 + tid)) * 8);
                    bf16_t* mp = MG + (size_t)(row0 + ai * HALF + m * 16) * 1024 + col0 + bj * HALF;
                    const f32x4 a0 = acc[ai][bj][m][0], a1 = acc[ai][bj][m][1];
                    float v[8] = {bf_lo(g.x) * a0[0], bf_hi(g.x) * a0[1], bf_lo(g.y) * a0[2], bf_hi(g.y) * a0[3], bf_lo(g.z) * a1[0], bf_hi(g.z) * a1[1], bf_lo(g.w) * a1[2], bf_hi(g.w) * a1[3]};
                    if (!first) { const u32x4 o = *(const u32x4*)mp;
                        v[0] += bf_lo(o.x); v[1] += bf_hi(o.x); v[2] += bf_lo(o.y); v[3] += bf_hi(o.y); v[4] += bf_lo(o.z); v[5] += bf_hi(o.z); v[6] += bf_lo(o.w); v[7] += bf_hi(o.w); }
                    u32x4 w; w.x = cvt_pk_bf16(v[0], v[1]); w.y = cvt_pk_bf16(v[2], v[3]); w.z = cvt_pk_bf16(v[4], v[5]); w.w = cvt_pk_bf16(v[6], v[7]);
                    *(u32x4*)mp = w;
                }
    }
};


struct EpiPart {
    static constexpr bool PERM = false, AFTER_DRAIN = false;
    float* P;
    __device__ __forceinline__ void operator()(const f32x4 (&acc)[2][2][4][2], const Unit& u, int wr, int wc, int fr, int fq) const {
        const int col0 = u.pn * BM + wc * 32 + 4 * fq;
#pragma unroll
        for (int ai = 0; ai < 2; ++ai)
#pragma unroll
            for (int m = 0; m < 4; ++m) {
                float* rp = P + (size_t)((u.pm - 64) * BM + ai * HALF + wr * 64 + m * 16 + fr) * 1024 + col0;
#pragma unroll
                for (int bj = 0; bj < 2; ++bj)
#pragma unroll
                    for (int n = 0; n < 2; ++n) *(f32x4*)(rp + bj * HALF + n * 16) = acc[ai][bj][m][n];
            }
    }
};
template <class Epi, class Sched, bool ALIGN_EPI = false, bool SP2 = false>
__device__ __forceinline__ void gemm_phase(PG8_LAS unsigned char* lds, const Gemm g, const Sched& S, const Epi& E) {
    const int tid = tid_now(), wid = __builtin_amdgcn_readfirstlane(tid >> 6), lane = tid & 63, wr = wid >> 2, wc = wid & 3, fr = lane & 15, fq = lane >> 4;
    const int K = g.K, nt = K / BK;
    unsigned voffA[2], voffB[2];
#pragma unroll
    for (int i = 0; i < 2; ++i) { int R, C; stage_rc(tid * 16 + i * 8192, R, C); const int Rb = Epi::PERM ? ((R & ~31) + perm32(R & 31)) : R;
        voffA[i] = (unsigned)(R * g.lda + C) * 2u; voffB[i] = (unsigned)(Rb * g.ldb + C) * 2u; }
    const size_t kstep = (size_t)(BK * 2);
    const size_t hsA = (size_t)HALF * g.lda * 2, hsB = (size_t)HALF * g.ldb * 2;
    const size_t tsA = 2 * hsA, tsB = 2 * hsB;
    const unsigned ldsw = (unsigned)wid * 1024u;
    const int aoff = lds_byte(wr * 64 + fr, fq * 8), boff = lds_byte(wc * 32 + fr, fq * 8);
#define PG8_SA(b, h) (((b) * 2 + (h)) * HTB)
#define PG8_SB(b, h) ((4 + (b) * 2 + (h)) * HTB)
#define PG8_STAGE(bufoff, gbase, voff) do { _Pragma("unroll") for (int _i = 0; _i < 2; ++_i) \
        __builtin_amdgcn_global_load_lds((const unsigned*)((const char*)(gbase) + (voff)[_i]), (PG8_LAS unsigned*)(lds + (bufoff) + ldsw + _i * 8192), 16, 0, 0); } while (0)
#define PG8_LDA(dst, b, h) do { _Pragma("unroll") for (int m = 0; m < 4; ++m) _Pragma("unroll") for (int k = 0; k < 2; ++k) dst[m][k] = *(const PG8_LAS bf16x8*)(lds + PG8_SA(b, h) + aoff + m * 2048 + k * 1024); } while (0)
#define PG8_LDB(dst, b, h) do { _Pragma("unroll") for (int n = 0; n < 2; ++n) _Pragma("unroll") for (int k = 0; k < 2; ++k) dst[n][k] = *(const PG8_LAS bf16x8*)(lds + PG8_SB(b, h) + boff + n * 2048 + k * 1024); } while (0)
#define PG8_MMA(ai, bj, At, Bt) do { __builtin_amdgcn_s_setprio(1); _Pragma("unroll") for (int m = 0; m < 4; ++m) _Pragma("unroll") for (int n = 0; n < 2; ++n) _Pragma("unroll") for (int k = 0; k < 2; ++k) \
        acc[ai][bj][m][n] = __builtin_amdgcn_mfma_f32_16x16x32_bf16(Bt[n][k], At[m][k], acc[ai][bj][m][n], 0, 0, 0); __builtin_amdgcn_s_setprio(0); } while (0)
#define PG8_WAIT_V(n) asm volatile("s_waitcnt vmcnt(" #n ")" ::: "memory")
#define PG8_WAIT_L(n) asm volatile("s_waitcnt lgkmcnt(" #n ")" ::: "memory")
#define PG8_BAR __builtin_amdgcn_s_barrier()
#define PG8_SCHED __builtin_amdgcn_sched_barrier(0)
    Unit cur, nxt; int ui = 0;
    if (!S.next(0, cur)) return;
    f32x4 acc[2][2][4][2];
#pragma unroll
    for (int a = 0; a < 2; ++a)
#pragma unroll
        for (int b = 0; b < 2; ++b)
#pragma unroll
            for (int m = 0; m < 4; ++m)
#pragma unroll
                for (int n = 0; n < 2; ++n) acc[a][b][m][n] = (f32x4){0.f, 0.f, 0.f, 0.f};
    bf16x8 At[4][2], B0[2][2], B1[2][2];
    const char* cA = (const char*)g.A + (size_t)cur.pm * tsA; const char* cB = (const char*)g.Bt + (size_t)cur.pn * tsB;
    S.a_ready(cur);
    if constexpr (SP2) {
        PG8_STAGE(PG8_SB(0, 0), cB, voffB); PG8_STAGE(PG8_SB(0, 1), cB + hsB, voffB); PG8_STAGE(PG8_SA(0, 0), cA, voffA); PG8_STAGE(PG8_SA(0, 1), cA + hsA, voffA);
        if (wr == 1) PG8_BAR;
        PG8_WAIT_V(2); PG8_BAR;
        PG8_STAGE(PG8_SB(1, 0), cB + kstep, voffB); PG8_STAGE(PG8_SA(1, 0), cA + kstep, voffA); PG8_STAGE(PG8_SB(1, 1), cB + hsB + kstep, voffB);
        PG8_WAIT_V(6); PG8_BAR;
    } else {
        PG8_STAGE(PG8_SB(0, 0), cB, voffB); PG8_STAGE(PG8_SA(0, 0), cA, voffA); PG8_STAGE(PG8_SB(0, 1), cB + hsB, voffB); PG8_STAGE(PG8_SA(0, 1), cA + hsA, voffA);
        if (wr == 1) PG8_BAR;
        PG8_WAIT_V(4); PG8_BAR;
        PG8_STAGE(PG8_SB(1, 0), cB + kstep, voffB); PG8_STAGE(PG8_SA(1, 0), cA + kstep, voffA); PG8_STAGE(PG8_SB(1, 1), cB + hsB + kstep, voffB);
        PG8_WAIT_V(6); PG8_BAR;
    }
    for (;;) {
        const bool has_next = S.next(ui + 1, nxt);
        const char* nA = has_next ? (const char*)g.A + (size_t)nxt.pm * tsA : cA; const char* nB = has_next ? (const char*)g.Bt + (size_t)nxt.pn * tsB : cB;
        for (int t = 0; t < nt; t += 2) {
            const bool last = (t == nt - 2);
            const char* a1 = cA + (size_t)(t + 1) * kstep;
            const char* a2 = last ? nA : cA + (size_t)(t + 2) * kstep; const char* b2 = last ? nB : cB + (size_t)(t + 2) * kstep;
            const char* a3 = a2 + kstep; const char* b3 = b2 + kstep;
            if (last && has_next) S.a_ready(nxt);
            if constexpr (SP2) {
            PG8_LDB(B0, 0, 0); PG8_LDB(B1, 0, 1); PG8_SCHED; PG8_LDA(At, 0, 0); PG8_STAGE(PG8_SA(1, 1), a1 + hsA, voffA);
            PG8_WAIT_V(8); PG8_WAIT_L(0); PG8_BAR; PG8_MMA(0, 0, At, B0); PG8_MMA(0, 1, At, B1); PG8_BAR; PG8_SCHED;
            PG8_LDA(At, 0, 1); PG8_STAGE(PG8_SB(0, 0), b2, voffB); PG8_STAGE(PG8_SB(0, 1), b2 + hsB, voffB); PG8_STAGE(PG8_SA(0, 0), a2, voffA);
            PG8_WAIT_V(8); PG8_WAIT_L(0); PG8_BAR; PG8_MMA(1, 0, At, B0); PG8_MMA(1, 1, At, B1); PG8_BAR; PG8_SCHED;
            PG8_LDB(B0, 1, 0); PG8_LDB(B1, 1, 1); PG8_SCHED; PG8_LDA(At, 1, 0); PG8_STAGE(PG8_SA(0, 1), a2 + hsA, voffA);
            PG8_WAIT_V(8); PG8_WAIT_L(0); PG8_BAR; PG8_MMA(0, 0, At, B0); PG8_MMA(0, 1, At, B1); PG8_BAR; PG8_SCHED;
            PG8_LDA(At, 1, 1); PG8_STAGE(PG8_SB(1, 0), b3, voffB); PG8_STAGE(PG8_SB(1, 1), b3 + hsB, voffB); PG8_STAGE(PG8_SA(1, 0), a3, voffA);
            PG8_WAIT_V(8); PG8_WAIT_L(0); PG8_BAR; PG8_MMA(1, 0, At, B0); PG8_MMA(1, 1, At, B1); PG8_BAR; PG8_SCHED;
            } else {
            PG8_LDB(B0, 0, 0); PG8_SCHED; PG8_LDA(At, 0, 0); PG8_STAGE(PG8_SA(1, 1), a1 + hsA, voffA);
            PG8_WAIT_L(8); PG8_BAR; PG8_WAIT_L(0); PG8_MMA(0, 0, At, B0); PG8_BAR; PG8_SCHED;
            PG8_LDB(B1, 0, 1); PG8_STAGE(PG8_SB(0, 0), b2, voffB);
            PG8_BAR; PG8_WAIT_L(0); PG8_MMA(0, 1, At, B1); PG8_BAR;
            PG8_LDA(At, 0, 1); PG8_STAGE(PG8_SA(0, 0), a2, voffA);
            PG8_BAR; PG8_WAIT_L(0); PG8_MMA(1, 0, At, B0); PG8_BAR; PG8_SCHED;
            PG8_STAGE(PG8_SB(0, 1), b2 + hsB, voffB);
            PG8_WAIT_V(6); PG8_BAR; PG8_MMA(1, 1, At, B1); PG8_BAR;
            PG8_LDB(B0, 1, 0); PG8_SCHED; PG8_LDA(At, 1, 0); PG8_STAGE(PG8_SA(0, 1), a2 + hsA, voffA);
            PG8_WAIT_L(8); PG8_BAR; PG8_WAIT_L(0); PG8_MMA(0, 0, At, B0); PG8_BAR; PG8_SCHED;
            PG8_LDB(B1, 1, 1); PG8_STAGE(PG8_SB(1, 0), b3, voffB);
            PG8_BAR; PG8_WAIT_L(0); PG8_MMA(0, 1, At, B1); PG8_BAR;
            PG8_LDA(At, 1, 1); PG8_STAGE(PG8_SA(1, 0), a3, voffA);
            PG8_BAR; PG8_WAIT_L(0); PG8_MMA(1, 0, At, B0); PG8_BAR; PG8_SCHED;
            PG8_STAGE(PG8_SB(1, 1), b3 + hsB, voffB);
            PG8_WAIT_V(6); PG8_BAR; PG8_MMA(1, 1, At, B1); PG8_BAR;
            }
        }
        if constexpr (ALIGN_EPI) { if (wr == 0) PG8_BAR; }
        if constexpr (!Epi::AFTER_DRAIN) { E(acc, cur, wr, wc, fr, fq); S.done(cur); }
        if (!has_next) break;
#pragma unroll
        for (int a = 0; a < 2; ++a)
#pragma unroll
            for (int b = 0; b < 2; ++b)
#pragma unroll
                for (int m = 0; m < 4; ++m)
#pragma unroll
                    for (int n = 0; n < 2; ++n) acc[a][b][m][n] = (f32x4){0.f, 0.f, 0.f, 0.f};
        cur = nxt; cA = nA; cB = nB; ++ui;
        if constexpr (ALIGN_EPI) { if (wr == 1) PG8_BAR; }
    }
    PG8_WAIT_V(0);
    if constexpr (!ALIGN_EPI) { if (wr == 0) PG8_BAR; }
    PG8_BAR;
    if constexpr (Epi::AFTER_DRAIN) { E.fused(acc, cur, wr, wc, fr, fq, lds, wid, lane); S.done(cur); }
#undef PG8_SA
#undef PG8_SB
#undef PG8_STAGE
#undef PG8_LDA
#undef PG8_LDB
#undef PG8_MMA
#undef PG8_WAIT_V
#undef PG8_WAIT_L
#undef PG8_BAR
#undef PG8_SCHED
}
}
namespace attn_body {
using bf16=__hip_bfloat16;
using bf16x8=__attribute__((ext_vector_type(8)))short;
using s16x4=__attribute__((ext_vector_type(4)))short;
using f32x16=__attribute__((ext_vector_type(16)))float;
using u32x4=__attribute__((ext_vector_type(4)))unsigned;
constexpr int D=64,QP=3328,OP=1024;
constexpr int NW=8,QBLK=32,QB=QBLK*NW,KVBLK=64;
constexpr int ATTN_UNIT_ROWS=QB;
__device__ __forceinline__ int crow(int r,int hi){return (r&3)+8*(r>>2)+4*hi;}
#define SBAR() __builtin_amdgcn_sched_barrier(0)
__device__ __forceinline__ void cmask(f32x16&p0,f32x16&p1,int jb,int qrel,int hi){
  const float NEG=-INFINITY; int kb=64*jb+4*hi;
  #pragma unroll
  for(int r=0;r<16;++r){int kv=kb+(r&3)+8*(r>>2); if(kv>qrel)p0[r]=NEG; if(kv+32>qrel)p1[r]=NEG;}
}

constexpr int NSLOT=3, SLOTB=8192;
constexpr int LDS_K=0, LDS_V=NSLOT*SLOTB, LDS_WS=2*NSLOT*SLOTB, LDS_OST=LDS_WS+NW*64*4, LDS_BYTES=LDS_OST+NW*4096;
constexpr float C2=0.125f*1.4426950408889634f;
__device__ __forceinline__ void glds16(const void*gsrc,unsigned lds_dst){unsigned keep;
  asm volatile("s_mov_b32 %0, m0\n\ts_mov_b32 m0, %2\n\ts_nop 0\n\tglobal_load_lds_dwordx4 %1, off\n\ts_mov_b32 m0, %0":"=&s"(keep):"v"(gsrc),"s"(lds_dst):"memory");}
__device__ __forceinline__ float max3f(float a,float b,float c){float r;asm("v_max3_f32 %0, %1, %2, %3":"=v"(r):"v"(a),"v"(b),"v"(c));return r;}
__device__ __forceinline__ float max2f(float a,float b){float r;asm("v_max_f32_e32 %0, %1, %2":"=v"(r):"v"(a),"v"(b));return r;}
__device__ __forceinline__ float fadd_s(float a,float b){float r;asm("v_add_f32_e32 %0, %1, %2":"=v"(r):"v"(a),"v"(b));return r;}
__device__ __forceinline__ float fsub_s(float a,float b){float r;asm("v_sub_f32_e32 %0, %1, %2":"=v"(r):"v"(a),"v"(b));return r;}
typedef float f32x2_t __attribute__((ext_vector_type(2))); typedef __bf16 bf16x2_t __attribute__((ext_vector_type(2)));
__device__ __forceinline__ unsigned cvtpk_s(float lo,float hi){f32x2_t v={lo,hi};bf16x2_t b=__builtin_convertvector(v,bf16x2_t);return __builtin_bit_cast(unsigned,b);}
#define WAIT_BAR(N) asm volatile("s_waitcnt vmcnt(" #N ") lgkmcnt(0)\n\ts_barrier":::"memory")

__device__ __forceinline__ void qkt(f32x16&p0,f32x16&p1,const char*Kslot,const bf16x8*qr,const f32x16&negm,int r32,int hi){
  const char*kb=Kslot+hi*1024+r32*16;
  #pragma unroll
  for(int d0=0;d0<4;++d0){
    const bf16x8 b0=*reinterpret_cast<const bf16x8*>(kb+d0*2048);
    const bf16x8 b1=*reinterpret_cast<const bf16x8*>(kb+d0*2048+512);
    if(d0==0){p0=__builtin_amdgcn_mfma_f32_32x32x16_bf16(b0,qr[0],negm,0,0,0);p1=__builtin_amdgcn_mfma_f32_32x32x16_bf16(b1,qr[0],negm,0,0,0);}
    else{p0=__builtin_amdgcn_mfma_f32_32x32x16_bf16(b0,qr[d0],p0,0,0,0);p1=__builtin_amdgcn_mfma_f32_32x32x16_bf16(b1,qr[d0],p1,0,0,0);}}
}
typedef __attribute__((address_space(3))) const char* lds_cptr;
typedef short v4i16_t __attribute__((ext_vector_type(4)));
__device__ __forceinline__ void kload8(bf16x8*kf,lds_cptr kp){
  kf[0]=*(const __attribute__((address_space(3))) bf16x8*)(kp);      kf[1]=*(const __attribute__((address_space(3))) bf16x8*)(kp+512);
  kf[2]=*(const __attribute__((address_space(3))) bf16x8*)(kp+2048); kf[3]=*(const __attribute__((address_space(3))) bf16x8*)(kp+2560);
  kf[4]=*(const __attribute__((address_space(3))) bf16x8*)(kp+4096); kf[5]=*(const __attribute__((address_space(3))) bf16x8*)(kp+4608);
  kf[6]=*(const __attribute__((address_space(3))) bf16x8*)(kp+6144); kf[7]=*(const __attribute__((address_space(3))) bf16x8*)(kp+6656);
}
__device__ __forceinline__ void kload2(bf16x8*kf,lds_cptr kp,int j){ kf[2*j]=*(const __attribute__((address_space(3))) bf16x8*)(kp+j*2048); kf[2*j+1]=*(const __attribute__((address_space(3))) bf16x8*)(kp+j*2048+512); }
__device__ __forceinline__ s16x4 vtr(lds_cptr p){ return __builtin_bit_cast(s16x4,__builtin_amdgcn_ds_read_tr16_b64_v4i16((__attribute__((address_space(3))) v4i16_t*)p)); }
__device__ __forceinline__ float rowmax(const f32x16&p0,const f32x16&p1){
  float a=max3f(p0[0],p0[1],p1[0]),b=max3f(p0[2],p0[3],p1[1]);a=max3f(a,p1[2],p1[3]);
  #pragma unroll
  for(int r=4;r<16;r+=4){a=max3f(a,p0[r],p0[r+1]);b=max3f(b,p0[r+2],p0[r+3]);a=max3f(a,p1[r],p1[r+1]);b=max3f(b,p1[r+2],p1[r+3]);}
  const float m=max2f(a,b);
  auto rr=__builtin_amdgcn_permlane32_swap(__float_as_uint(m),__float_as_uint(m),false,false);
  return max2f(__uint_as_float(rr[0]),__uint_as_float(rr[1]));
}
__device__ __forceinline__ void pv(f32x16*o,int vb,bf16x8 pa0,bf16x8 pa1,bf16x8 pa2,bf16x8 pa3){
  #pragma unroll
  for(int d0=0;d0<2;++d0){s16x4 lo[4],hi[4];
    #pragma unroll
    for(int ks=0;ks<4;++ks){
      asm volatile("ds_read_b64_tr_b16 %0,%1 offset:%c2":"=&v"(lo[ks]):"v"(vb),"i"(d0*4096+ks*1024):"memory");
      asm volatile("ds_read_b64_tr_b16 %0,%1 offset:%c2":"=&v"(hi[ks]):"v"(vb),"i"(d0*4096+ks*1024+512):"memory");}
    asm volatile("s_waitcnt lgkmcnt(0)":::"memory");SBAR();
    #define PK(k) (bf16x8){lo[k][0],lo[k][1],lo[k][2],lo[k][3],hi[k][0],hi[k][1],hi[k][2],hi[k][3]}
    o[d0]=__builtin_amdgcn_mfma_f32_32x32x16_bf16(pa0,PK(0),o[d0],0,0,0);
    o[d0]=__builtin_amdgcn_mfma_f32_32x32x16_bf16(pa1,PK(1),o[d0],0,0,0);
    o[d0]=__builtin_amdgcn_mfma_f32_32x32x16_bf16(pa2,PK(2),o[d0],0,0,0);
    o[d0]=__builtin_amdgcn_mfma_f32_32x32x16_bf16(pa3,PK(3),o[d0],0,0,0);
    #undef PK
  }
}

#ifndef ATTN_STORE16
#define ATTN_STORE16(p,v) (*(u32x4*)(p)=(v))
#endif
template<int THRL> __device__ __forceinline__ void attn_unit(const bf16*Qu,const bf16*__restrict__ Kc,const bf16*__restrict__ Vc,bf16*Ou,int krow0,int nt_main,int krow1,int NT,char*shm){
  const int tid=tid_now(),lane=tid&63,r32=lane&31,hi=lane>>5; const int wid=__builtin_amdgcn_readfirstlane(tid>>6);
  const bf16*Qw=Qu+(long)(wid*QBLK)*QP;
  const unsigned lds0=(unsigned)(uintptr_t)shm;
  float*wsf=(float*)(shm+LDS_WS)+wid*64;
  const bf16*ksrc=Kc+(long)lane*QP+wid*8;
  const bf16*vsrc=Vc+(long)(16*(wid&3)+(lane>>2))*QP+(wid>>2)*32+(lane&3)*8;
  const unsigned kdst=lds0+LDS_K+wid*1024, vdst=lds0+LDS_V+wid*1024;
  #define KROW(t) (((t)<nt_main)?(krow0+(t)*KVBLK):(krow1+((t)-nt_main)*KVBLK))
  #define DMA_K(t,slot) glds16(ksrc+(long)KROW(t)*QP,(unsigned)__builtin_amdgcn_readfirstlane(kdst+(slot)))
  #define DMA_V(t,slot) glds16(vsrc+(long)KROW(t)*QP,(unsigned)__builtin_amdgcn_readfirstlane(vdst+(slot)))
  const int vb0=(int)(lds0+LDS_V)+((lane>>4)&1)*32+(lane&3)*8+(4*hi+((lane&15)>>2))*64;
  const char*Kbase=shm+LDS_K; bf16x8 kf[8];
  const lds_cptr shm3=(lds_cptr)shm; const lds_cptr kp0=shm3+LDS_K+hi*1024+r32*16; const lds_cptr vp0=shm3+LDS_V+((lane>>4)&1)*32+(lane&3)*8+(4*hi+((lane&15)>>2))*64;
  DMA_K(0,0);DMA_V(0,0);DMA_K(1,SLOTB);
  bf16x8 qr[4];
  #pragma unroll
  for(int d0=0;d0<4;++d0)qr[d0]=*reinterpret_cast<const bf16x8*>(&Qw[(long)r32*QP+d0*16+hi*8]);
  float mhat=0.f,l_reg=0.f;f32x16 o[2];o[0]=f32x16{};o[1]=f32x16{};f32x16 negm=f32x16{};asm volatile("":"+v"(negm));
  const int qrel=wid*QBLK+r32;
  #define CMASK(P0,P1,t) do{}while(0)
  bool resc=false;
  #define START(P0,P1) do{ const float rm=rowmax(P0,P1); resc=false; \
    { const float dl=rm; mhat=fadd_s(mhat,dl); \
      _Pragma("unroll") for(int r=0;r<16;++r){P0[r]=fsub_s(P0[r],dl);P1[r]=fsub_s(P1[r],dl);} \
      _Pragma("unroll") for(int r=0;r<16;++r)negm[r]=-mhat; asm volatile("":"+v"(negm)); } \
    _Pragma("unroll") for(int r=0;r<16;++r)P0[r]=__builtin_amdgcn_exp2f(P0[r]); }while(0)
  #define RESC() do{ if(resc){ asm volatile("s_waitcnt lgkmcnt(0)":::"memory"); \
      _Pragma("unroll") for(int d_=0;d_<2;++d_) _Pragma("unroll") for(int r=0;r<16;++r)o[d_][r]*=wsf[crow(r,hi)]; } }while(0)
  f32x16 pA0,pA1,pB0,pB1;
  int sl_prev=0,sl_cur=0,sl_next=SLOTB;
  #define ROT() do{sl_prev=sl_cur;sl_cur=sl_next;sl_next=(sl_next==(NSLOT-1)*SLOTB)?0:sl_next+SLOTB;}while(0)
  DMA_K(2,2*SLOTB);
  WAIT_BAR(3);
  qkt(pA0,pA1,Kbase,qr,negm,r32,hi);asm volatile("s_nop 15\n\ts_nop 7":"+v"(pA0),"+v"(pA1));CMASK(pA0,pA1,0);
  START(pA0,pA1);
  _Pragma("unroll") for(int r=0;r<16;++r)pA1[r]=__builtin_amdgcn_exp2f(pA1[r]);
  WAIT_BAR(0);
  DMA_K(3,0);DMA_V(1,SLOTB);
  ROT();
  kload8(kf,kp0+sl_cur);
  WAIT_BAR(2);
  s16x4 vlo[8],vhi[8]; u32x4 pw0,pw1,pw2,pw3;
  #define PKW(P,B) cvtpk_s(P[B],P[B+1])
  #define PAF(k) __builtin_bit_cast(bf16x8,pw##k)
  #define VFR(i) (bf16x8){vlo[i][0],vlo[i][1],vlo[i][2],vlo[i][3],vhi[i][0],vhi[i][1],vhi[i][2],vhi[i][3]}
  #define PIN(x) asm volatile("":"+v"(x))
  #define MX3(a,b,c) __builtin_fmaxf(__builtin_fmaxf((a),(b)),(c))
  #define GAPA(MF,A0,A1,A2,A3,W0,W1,PW) do{ MF; sacc+=A0; sacc+=A1; sacc+=A2; sacc+=A3; PIN(sacc); W0; W1; PIN(PW); SBAR(); }while(0)
  #define EX(v) __builtin_amdgcn_exp2f(v)
  #define GAPB(MF,X,B) do{ MF; X[B]=EX(X[B]); X[B+1]=EX(X[B+1]); X[B+2]=EX(X[B+2]); X[B+3]=EX(X[B+3]); PIN(X); SBAR(); }while(0)
  #define VRD(i) do{ vlo[i]=vtr(vp_+(((i)>>2)*4096+((i)&3)*1024)); vhi[i]=vtr(vp_+(((i)>>2)*4096+((i)&3)*1024+512)); }while(0)
  #define KRD(G,j) do{ if(G){ kload2(kf,kp0+sl_next,j); SBAR(); } }while(0)
  #define STEP(C0,C1,P0,P1,t,GK,GV,GL) do{ SBAR(); \
    const lds_cptr vp_=vp0+sl_prev; \
    VRD(0); SBAR(); float sacc=(P0[0]+P0[1]); \
    GAPA(C0=__builtin_amdgcn_mfma_f32_32x32x16_bf16(kf[0],qr[0],negm,0,0,0), P0[2],P0[3],P0[4],P0[5],     pw0[0]=PKW(P0,0), pw0[1]=PKW(P0,2), pw0); \
    VRD(4); SBAR(); GAPA(C1=__builtin_amdgcn_mfma_f32_32x32x16_bf16(kf[1],qr[0],negm,0,0,0), P0[6],P0[7],P0[8],P0[9],     pw0[2]=PKW(P0,4), pw0[3]=PKW(P0,6), pw0); \
    VRD(1); SBAR(); GAPA(C0=__builtin_amdgcn_mfma_f32_32x32x16_bf16(kf[2],qr[1],C0,0,0,0),   P0[10],P0[11],P0[12],P0[13], pw1[0]=PKW(P0,8), pw1[1]=PKW(P0,10), pw1); \
    VRD(5); SBAR(); GAPA(C1=__builtin_amdgcn_mfma_f32_32x32x16_bf16(kf[3],qr[1],C1,0,0,0),   P0[14],P0[15],P1[0],P1[1],   pw1[2]=PKW(P0,12),pw1[3]=PKW(P0,14), pw1); \
    VRD(2); SBAR(); GAPA(C0=__builtin_amdgcn_mfma_f32_32x32x16_bf16(kf[4],qr[2],C0,0,0,0),   P1[2],P1[3],P1[4],P1[5],     pw2[0]=PKW(P1,0), pw2[1]=PKW(P1,2), pw2); \
    VRD(6); SBAR(); GAPA(C1=__builtin_amdgcn_mfma_f32_32x32x16_bf16(kf[5],qr[2],C1,0,0,0),   P1[6],P1[7],P1[8],P1[9],     pw2[2]=PKW(P1,4), pw2[3]=PKW(P1,6), pw2); \
    VRD(3); SBAR(); GAPA(C0=__builtin_amdgcn_mfma_f32_32x32x16_bf16(kf[6],qr[3],C0,0,0,0),   P1[10],P1[11],P1[12],P1[13], pw3[0]=PKW(P1,8), pw3[1]=PKW(P1,10), pw3); \
    VRD(7); SBAR(); GAPA(C1=__builtin_amdgcn_mfma_f32_32x32x16_bf16(kf[7],qr[3],C1,0,0,0),   P1[14],P1[15],0.f,0.f,       pw3[2]=PKW(P1,12),pw3[3]=PKW(P1,14), pw3); \
    l_reg+=sacc; \
    if(GK){DMA_K((t)+3,sl_cur);} if(GV){DMA_V((t)+1,sl_next);} \
    CMASK(C0,C1,t); \
    { float a=MX3(C0[0],C0[1],C1[0]),b=MX3(C0[2],C0[3],C1[1]); a=MX3(a,C1[2],C1[3]); \
      _Pragma("unroll") for(int r=4;r<16;r+=4){a=MX3(a,C0[r],C0[r+1]);b=MX3(b,C0[r+2],C0[r+3]);a=MX3(a,C1[r],C1[r+1]);b=MX3(b,C1[r+2],C1[r+3]);} \
      float rm=__builtin_fmaxf(a,b); { auto rr=__builtin_amdgcn_permlane32_swap(__float_as_uint(rm),__float_as_uint(rm),false,false); rm=__builtin_fmaxf(__uint_as_float(rr[0]),__uint_as_float(rr[1])); } \
      resc=false; \
      if(__builtin_expect(__any(rm>(float)THRL),0)){ const float dl=__builtin_fmaxf(rm,0.f); mhat+=dl; \
        _Pragma("unroll") for(int r=0;r<16;++r){C0[r]-=dl;C1[r]-=dl;} \
        _Pragma("unroll") for(int r=0;r<16;++r)negm[r]=-mhat; asm volatile("":"+v"(negm)); \
        const float f=__builtin_amdgcn_exp2f(-dl); l_reg*=f; if(hi==0)wsf[r32]=f; resc=true; } } \
    SBAR(); \
    GAPB(o[0]=__builtin_amdgcn_mfma_f32_32x32x16_bf16(PAF(0),VFR(0),o[0],0,0,0), C0,0); \
    GAPB(o[1]=__builtin_amdgcn_mfma_f32_32x32x16_bf16(PAF(0),VFR(4),o[1],0,0,0), C0,4); \
    KRD(GL,0); GAPB(o[0]=__builtin_amdgcn_mfma_f32_32x32x16_bf16(PAF(1),VFR(1),o[0],0,0,0), C0,8); \
    KRD(GL,1); GAPB(o[1]=__builtin_amdgcn_mfma_f32_32x32x16_bf16(PAF(1),VFR(5),o[1],0,0,0), C0,12); \
    KRD(GL,2); GAPB(o[0]=__builtin_amdgcn_mfma_f32_32x32x16_bf16(PAF(2),VFR(2),o[0],0,0,0), C1,0); \
    KRD(GL,3); GAPB(o[1]=__builtin_amdgcn_mfma_f32_32x32x16_bf16(PAF(2),VFR(6),o[1],0,0,0), C1,4); \
    GAPB(o[0]=__builtin_amdgcn_mfma_f32_32x32x16_bf16(PAF(3),VFR(3),o[0],0,0,0), C1,8); \
    GAPB(o[1]=__builtin_amdgcn_mfma_f32_32x32x16_bf16(PAF(3),VFR(7),o[1],0,0,0), C1,12); \
    }while(0)
  int t=1;
  #undef CMASK
  #define CMASK(P0,P1,t) do{}while(0)
  for(;t+5<NT;t+=2){
    STEP(pB0,pB1,pA0,pA1,t,true,true,true);     WAIT_BAR(2); RESC(); ROT();
    STEP(pA0,pA1,pB0,pB1,t+1,true,true,true);   WAIT_BAR(2); RESC(); ROT();
  }
  #undef CMASK
  #define CMASK(P0,P1,t) do{}while(0)
  #define ENDW(tt) do{ if((tt)+3<NT){WAIT_BAR(2);} else if((tt)+2<NT){WAIT_BAR(1);} else {WAIT_BAR(0);} }while(0)
  for(;t+1<NT;t+=2){
    STEP(pB0,pB1,pA0,pA1,t,(t+3<NT),(t+1<NT),(t+1<NT));       ENDW(t);   RESC(); ROT();
    STEP(pA0,pA1,pB0,pB1,t+1,(t+4<NT),(t+2<NT),(t+2<NT));     ENDW(t+1); RESC(); ROT();
  }
  STEP(pB0,pB1,pA0,pA1,NT-1,false,false,false); RESC();
  { float sacc=pB0[0]+pB0[1]; _Pragma("unroll") for(int r=2;r<16;++r)sacc+=pB0[r]; _Pragma("unroll") for(int r=0;r<16;++r)sacc+=pB1[r]; l_reg+=sacc;
    pw0=(u32x4){PKW(pB0,0),PKW(pB0,2),PKW(pB0,4),PKW(pB0,6)};pw1=(u32x4){PKW(pB0,8),PKW(pB0,10),PKW(pB0,12),PKW(pB0,14)};pw2=(u32x4){PKW(pB1,0),PKW(pB1,2),PKW(pB1,4),PKW(pB1,6)};pw3=(u32x4){PKW(pB1,8),PKW(pB1,10),PKW(pB1,12),PKW(pB1,14)};
    SBAR(); pv(o,vb0+sl_cur,PAF(0),PAF(1),PAF(2),PAF(3)); }
  #undef PKW
  #undef PAF
  #undef VFR
  #undef PIN
  #undef MX3
  #undef GAPA
  #undef GAPB
  #undef EX
  #undef VRD
  #undef KRD
  #undef STEP
  #undef ENDW
  {auto rr=__builtin_amdgcn_permlane32_swap(__float_as_uint(l_reg),__float_as_uint(l_reg),false,false);l_reg=__uint_as_float(rr[0])+__uint_as_float(rr[1]);}
  if(hi==0)wsf[32+r32]=l_reg;asm volatile("s_waitcnt lgkmcnt(0)":::"memory");
  float rli[16];
  #pragma unroll
  for(int r=0;r<16;++r)rli[r]=__builtin_amdgcn_rcpf(wsf[32+crow(r,hi)]);
  bf16*Ow=Ou+(long)(wid*QBLK)*OP;
  { bf16*stg=(bf16*)(shm+LDS_OST)+wid*2048;
    #pragma unroll
    for(int r=0;r<16;++r){const int orow=crow(r,hi);
      #pragma unroll
      for(int d0=0;d0<2;++d0)stg[orow*64+d0*32+r32]=__float2bfloat16(o[d0][r]*rli[r]);}
    asm volatile("s_waitcnt lgkmcnt(0)":::"memory");
    #pragma unroll
    for(int i=0;i<4;++i){const int row=i*8+(lane>>3),ch=lane&7; const u32x4 v=*(const u32x4*)(stg+row*64+ch*8); ATTN_STORE16(Ow+(long)row*OP+ch*8,v);} }
  asm volatile("s_waitcnt lgkmcnt(0)\n\ts_barrier":::"memory");
  #undef DMA_K
  #undef KROW
  #undef DMA_V
  #undef CMASK
  #undef START
  #undef RESC
  #undef ROT
}

__device__ __forceinline__ void pv16(f32x16*o,int vb,bf16x8 pa0,bf16x8 pa1,bf16x8 pa2,bf16x8 pa3){
  pv(o,vb,pa0,pa1,pa2,pa3); pv(o+2,vb+8192,pa0,pa1,pa2,pa3);
}
template<int THRL> __device__ __forceinline__ void attn_unit2(const bf16*Qu,const bf16*__restrict__ Kc,const bf16*__restrict__ Vc,bf16*Ou,int krow0,int nt_main,int krow1,int NT,char*shm){
  const int tid=tid_now(),lane=tid&63,r32=lane&31,hi=lane>>5; const int wid=__builtin_amdgcn_readfirstlane(tid>>6);
  const bool grpB=wid>=4;
  constexpr int KS=8192,VS=16384,L_K=0,L_V=4*KS,L_WS=L_V+4*VS,L_OST=0;
  const bf16*Qw=Qu+(long)(wid*QBLK)*QP;
  const unsigned lds0=(unsigned)(uintptr_t)shm;
  float*wsf=(float*)(shm+L_WS)+wid*64;
  const bf16*ksrc=Kc+(long)lane*QP+wid*8;
  const bf16*vsrc=Vc+(long)(16*(wid&3)+(lane>>2))*QP+(wid>>2)*32+(lane&3)*8;
  const unsigned kdst=lds0+L_K+wid*1024, vdst=lds0+L_V+wid*1024;
  #define KROW2(t) (((t)<nt_main)?(krow0+(t)*KVBLK):(krow1+((t)-nt_main)*KVBLK))
  #define DMA2(t,s) do{ const long ro_=(long)KROW2(t)*QP; glds16(ksrc+ro_,(unsigned)__builtin_amdgcn_readfirstlane(kdst+(s)*KS)); \
      glds16(vsrc+ro_,(unsigned)__builtin_amdgcn_readfirstlane(vdst+(s)*VS)); glds16(vsrc+ro_+64,(unsigned)__builtin_amdgcn_readfirstlane(vdst+(s)*VS+8192)); }while(0)
  const int vb0=(int)(lds0+L_V)+((lane>>4)&1)*32+(lane&3)*8+(4*hi+((lane&15)>>2))*64;
  DMA2(0,0); if(NT>1) DMA2(1,1);
  bf16x8 qr[4];
  #pragma unroll
  for(int d0=0;d0<4;++d0)qr[d0]=*reinterpret_cast<const bf16x8*>(&Qw[(long)r32*QP+d0*16+hi*8]);
  float mhat=0.f,l_reg=0.f; f32x16 o[4]; o[0]=f32x16{};o[1]=f32x16{};o[2]=f32x16{};o[3]=f32x16{}; f32x16 negm=f32x16{};
  u32x4 pw0=u32x4{},pw1=u32x4{},pw2=u32x4{},pw3=u32x4{};
  int sl=0,slp=0;
  for(int t=0;t<NT;++t){
    if(t+1<NT) asm volatile("s_waitcnt vmcnt(3) lgkmcnt(0)\n\ts_barrier":::"memory"); else asm volatile("s_waitcnt vmcnt(0) lgkmcnt(0)\n\ts_barrier":::"memory");
    if(t+2<NT){ DMA2(t+2,(sl+2)&3); }
    if(grpB&&t>0) pv16(o,vb0+slp*VS,__builtin_bit_cast(bf16x8,pw0),__builtin_bit_cast(bf16x8,pw1),__builtin_bit_cast(bf16x8,pw2),__builtin_bit_cast(bf16x8,pw3));
    f32x16 p0,p1; qkt(p0,p1,shm+L_K+sl*KS,qr,negm,r32,hi);
    float rm=p0[0];
    #pragma unroll
    for(int r=0;r<16;++r){ rm=__builtin_fmaxf(rm,p0[r]); rm=__builtin_fmaxf(rm,p1[r]); }
    { auto rr=__builtin_amdgcn_permlane32_swap(__float_as_uint(rm),__float_as_uint(rm),false,false); rm=__builtin_fmaxf(__uint_as_float(rr[0]),__uint_as_float(rr[1])); }
    bool resc=false;
    if(t==0){ mhat=rm;
      #pragma unroll
      for(int r=0;r<16;++r){p0[r]-=rm;p1[r]-=rm;}
      #pragma unroll
      for(int r=0;r<16;++r)negm[r]=-mhat; }
    else if(__any(rm>(float)THRL)){ const float dl=__builtin_fmaxf(rm,0.f); mhat+=dl;
      #pragma unroll
      for(int r=0;r<16;++r){p0[r]-=dl;p1[r]-=dl;}
      #pragma unroll
      for(int r=0;r<16;++r)negm[r]=-mhat;
      const float f=__builtin_amdgcn_exp2f(-dl); l_reg*=f; if(hi==0)wsf[r32]=f; resc=true; }
    float sacc=0.f;
    #pragma unroll
    for(int r=0;r<16;++r){ p0[r]=__builtin_amdgcn_exp2f(p0[r]); p1[r]=__builtin_amdgcn_exp2f(p1[r]); sacc+=p0[r]+p1[r]; }
    l_reg+=sacc;
    pw0=(u32x4){cvtpk_s(p0[0],p0[1]),cvtpk_s(p0[2],p0[3]),cvtpk_s(p0[4],p0[5]),cvtpk_s(p0[6],p0[7])};
    pw1=(u32x4){cvtpk_s(p0[8],p0[9]),cvtpk_s(p0[10],p0[11]),cvtpk_s(p0[12],p0[13]),cvtpk_s(p0[14],p0[15])};
    pw2=(u32x4){cvtpk_s(p1[0],p1[1]),cvtpk_s(p1[2],p1[3]),cvtpk_s(p1[4],p1[5]),cvtpk_s(p1[6],p1[7])};
    pw3=(u32x4){cvtpk_s(p1[8],p1[9]),cvtpk_s(p1[10],p1[11]),cvtpk_s(p1[12],p1[13]),cvtpk_s(p1[14],p1[15])};
    if(resc){ asm volatile("s_waitcnt lgkmcnt(0)":::"memory");
      #pragma unroll
      for(int r=0;r<16;++r){ const float f=wsf[crow(r,hi)];
        #pragma unroll
        for(int d_=0;d_<4;++d_) o[d_][r]*=f; } }
    if(!grpB) pv16(o,vb0+sl*VS,__builtin_bit_cast(bf16x8,pw0),__builtin_bit_cast(bf16x8,pw1),__builtin_bit_cast(bf16x8,pw2),__builtin_bit_cast(bf16x8,pw3));
    slp=sl; sl=(sl+1)&3;
  }
  if(grpB) pv16(o,vb0+slp*VS,__builtin_bit_cast(bf16x8,pw0),__builtin_bit_cast(bf16x8,pw1),__builtin_bit_cast(bf16x8,pw2),__builtin_bit_cast(bf16x8,pw3));
  asm volatile("s_waitcnt lgkmcnt(0)\n\ts_barrier":::"memory");
  {auto rr=__builtin_amdgcn_permlane32_swap(__float_as_uint(l_reg),__float_as_uint(l_reg),false,false);l_reg=__uint_as_float(rr[0])+__uint_as_float(rr[1]);}
  if(hi==0)wsf[32+r32]=l_reg; asm volatile("s_waitcnt lgkmcnt(0)":::"memory");
  float rli[16];
  #pragma unroll
  for(int r=0;r<16;++r)rli[r]=__builtin_amdgcn_rcpf(wsf[32+crow(r,hi)]);
  bf16*Ow=Ou+(long)(wid*QBLK)*OP; bf16*stg=(bf16*)(shm+L_OST)+wid*2048;
  #pragma unroll
  for(int e=0;e<2;++e){
    #pragma unroll
    for(int r=0;r<16;++r){const int orow=crow(r,hi);
      #pragma unroll
      for(int d0=0;d0<2;++d0)stg[orow*64+d0*32+r32]=__float2bfloat16(o[2*e+d0][r]*rli[r]);}
    asm volatile("s_waitcnt lgkmcnt(0)":::"memory");
    #pragma unroll
    for(int i=0;i<4;++i){const int row=i*8+(lane>>3),ch=lane&7; const u32x4 v=*(const u32x4*)(stg+row*64+ch*8); ATTN_STORE16(Ow+(long)row*OP+e*64+ch*8,v);}
    asm volatile("s_waitcnt lgkmcnt(0)":::"memory");
  }
  asm volatile("s_waitcnt lgkmcnt(0)\n\ts_barrier":::"memory");
  #undef KROW2
  #undef DMA2
}
constexpr int ATTN_LDS_BYTES=LDS_BYTES;
#undef SBAR
#undef WAIT_BAR
}

#define LAS __attribute__((address_space(3)))
typedef unsigned short bf16;
typedef float f32x4 __attribute__((ext_vector_type(4)));
typedef unsigned u32x4 __attribute__((ext_vector_type(4)));
typedef unsigned u32x2 __attribute__((ext_vector_type(2)));
using pg8::cvt_pk_bf16; using pg8::bf_lo; using pg8::bf_hi; using pg8::fsigmoid; using pg8::fsilu;

constexpr int NWAVES = 8, NTHR = 512;
constexpr int DM = 1024, NX = 16384, NCTX = 1024, MT = NX + NCTX, SEQ = 4096, CTXL = 256, FF = 2816, PXW = 3328, MODW = 9216, INC = 7424;
constexpr int A_OFF = 0, B_OFF = 768, Q_OFF = 1280, K_OFF = 1792, V_OFF = 2304, D_OFF = 2816, G_OFF = 3328;
constexpr float EPS = 1e-6f;
constexpr float C2 = 0.125f * 1.4426950408889634f;
constexpr int LDS_BYTES = 147456;

constexpr size_t MiB = 1u << 20;
constexpr size_t WS_MOD = 0;
constexpr size_t WS_ROPE = 512 * 1024;
constexpr size_t WS_LAM = WS_ROPE + 16384;
constexpr size_t WS_BAR = 640 * 1024;
constexpr size_t WS_W = 1 * MiB;
constexpr size_t LW_UP1 = 0, LW_DN1 = LW_UP1 + (size_t)5632 * 1024, LW_UP2 = LW_DN1 + (size_t)1024 * 2816, LW_DN2 = LW_UP2 + (size_t)5632 * 1024,
                 LW_WIN = LW_DN2 + (size_t)1024 * 2816, LW_AO = LW_WIN + (size_t)INC * 1024, LW_BO = LW_AO + 262144, LW_DO = LW_BO + 262144,
                 LW_CO = LW_DO + 262144, LW_O = LW_CO + 524288, LW_TOTAL = LW_O + 1048576;
static_assert(LW_TOTAL * 2 == 52 * MiB, "weights per layer");
constexpr size_t WS_HN = 105 * MiB;
constexpr size_t WS_PX = 139 * MiB;
constexpr size_t WS_OB = 250 * MiB;
constexpr size_t WS_GS = 284 * MiB;
constexpr size_t WS_ACTD = 316 * MiB;
constexpr size_t WS_CTX = 325 * MiB;
constexpr size_t WS_MGP = 329 * MiB;
constexpr size_t WS_END = 337 * MiB;
constexpr size_t WS_PART = WS_GS;
static_assert(WS_HN + (size_t)MT * 1024 * 2 <= WS_PX && WS_PX + (size_t)MT * PXW * 2 <= WS_OB && WS_OB + (size_t)MT * 1024 * 2 <= WS_GS && WS_ACTD + (size_t)MT * 256 * 2 <= WS_CTX, "ws map");

#define GAS __attribute__((address_space(1)))
#define XB_TMO      128
#define XB_XCNT(j)  (256  + 64 * (j))
#define XB_XSUB(j)  (1280 + 64 * (j))
#define XB_XGEN(j)  (2304 + 64 * (j))
#define XB_TOP      3328
#define XB_TOPGEN   3392
#define XCD_BAR_WORDS 3456
#define XB_SPIN_CAP (1u << 18)

__device__ __forceinline__ unsigned xb_ld(unsigned* p)              { return __hip_atomic_load(p, __ATOMIC_RELAXED, __HIP_MEMORY_SCOPE_AGENT); }
__device__ __forceinline__ unsigned xb_add(unsigned* p, unsigned v) { return __hip_atomic_fetch_add(p, v, __ATOMIC_RELAXED, __HIP_MEMORY_SCOPE_AGENT); }
__device__ __forceinline__ unsigned xb_xcc_id() { return (unsigned)__builtin_amdgcn_s_getreg((3 << 11) | 20) & 0xFu; }
#define XB_SPIN(cond, bar) do { unsigned _sp = 0; while (cond) { __builtin_amdgcn_s_sleep(1); \
    if ((++_sp & 255u) == 0u) { if (xb_ld(&(bar)[XB_TMO])) break; if (_sp > XB_SPIN_CAP) { atomicAdd(&(bar)[XB_TMO], 1u); break; } } } } while (0)

struct XcdBarrier {
    unsigned* bar; unsigned x;
    volatile LAS unsigned* st;
};

__device__ __forceinline__ XcdBarrier xcd_barrier_post(unsigned* bar, volatile LAS unsigned* st) {
    XcdBarrier b; b.bar = bar; b.x = xb_xcc_id(); b.st = st;
    if (threadIdx.x == 0) (void)xb_add(&bar[XB_XCNT(b.x)], 1u);
    return b;
}
__device__ __forceinline__ void xcd_barrier_complete(unsigned* bar, unsigned x, unsigned& nloc, unsigned& nx) {
    const unsigned G = gridDim.x * gridDim.y * gridDim.z;
    unsigned sum, cnt, mine, sp = 0u;
    for (;;) {
        sum = 0u; cnt = 0u; mine = 0u;
#pragma unroll
        for (unsigned j = 0; j < 16; ++j) { const unsigned c = xb_ld(&bar[XB_XCNT(j)]); sum += c; cnt += (c > 0u) ? 1u : 0u; mine = (j == x) ? c : mine; }
        if (sum == G) break;
        __builtin_amdgcn_s_sleep(1);
        if ((++sp & 255u) == 0u) { if (xb_ld(&bar[XB_TMO])) break; if (sp > XB_SPIN_CAP) { atomicAdd(&bar[XB_TMO], 1u); break; } }
    }
    nloc = mine > 0u ? mine : 1u; nx = cnt > 0u ? cnt : 1u;
}

__device__ __forceinline__ void xcd_barrier(const XcdBarrier& b) {
    asm volatile("s_waitcnt vmcnt(0)" ::: "memory");
    __syncthreads();
    if (threadIdx.x == 0) {
        unsigned* bar = b.bar;
        __builtin_amdgcn_s_waitcnt(0);
        unsigned nloc = b.st[0], nx = b.st[1];
        if (nloc == 0u) { xcd_barrier_complete(bar, b.x, nloc, nx); b.st[0] = nloc; b.st[1] = nx; }
        const unsigned old = xb_add(&bar[XB_XSUB(b.x)], 1u);
        const unsigned gen = old / nloc;
        if (old + 1u == (gen + 1u) * nloc) {
            __builtin_amdgcn_fence(__ATOMIC_RELEASE, "agent");
            asm volatile("s_waitcnt vmcnt(0)" ::: "memory");
            const unsigned og = xb_add(&bar[XB_TOP], 1u);
            const unsigned tg = og / nx;
            if (og + 1u == (tg + 1u) * nx) xb_add(&bar[XB_TOPGEN], 1u);
            else XB_SPIN(xb_ld(&bar[XB_TOPGEN]) == tg, bar);
            __builtin_amdgcn_fence(__ATOMIC_ACQUIRE, "agent");
            xb_add(&bar[XB_XGEN(b.x)], 1u);
            asm volatile("s_waitcnt vmcnt(0)" ::: "memory");
        } else {
            XB_SPIN(xb_ld(&bar[XB_XGEN(b.x)]) == gen, bar);
            __builtin_amdgcn_fence(__ATOMIC_ACQUIRE, "agent");
            asm volatile("s_waitcnt vmcnt(0)" ::: "memory");
        }
    }
    __syncthreads();
}

struct Params { const float* in[29]; float* out; unsigned char* ws; int ph_lo, ph_hi; };
typedef __attribute__((address_space(4))) const Params* KP;

__device__ __forceinline__ float wave_sum(float v) {
#pragma unroll
    for (int o = 1; o < 64; o <<= 1) v += __shfl_xor(v, o);
    return v;
}

__device__ __forceinline__ void transpose_item(const float* W, int K, int N, bf16* WT, LAS float* scr, int k0, int n0, int drow0, int lane) {
#pragma unroll 8
    for (int i = 0; i < 32; ++i) { const int kk = 2 * i + (lane >> 5); scr[kk * 33 + (lane & 31)] = W[(size_t)(k0 + kk) * N + n0 + (lane & 31)]; }
    asm volatile("s_waitcnt lgkmcnt(0)" ::: "memory");
    const int c = lane & 7;
#pragma unroll
    for (int j = 0; j < 4; ++j) { const int n = (lane >> 3) + 8 * j; const LAS float* s = scr + (8 * c) * 33 + n;
        u32x4 o; o.x = cvt_pk_bf16(s[0 * 33], s[1 * 33]); o.y = cvt_pk_bf16(s[2 * 33], s[3 * 33]); o.z = cvt_pk_bf16(s[4 * 33], s[5 * 33]); o.w = cvt_pk_bf16(s[6 * 33], s[7 * 33]);
        *(u32x4*)(WT + (size_t)(drow0 + n) * K + k0 + 8 * c) = o; }
    asm volatile("s_waitcnt lgkmcnt(0)" ::: "memory");
}
__device__ __forceinline__ bool transpose_mat(int& r, const float* W, int K, int N, bf16* WT, int mode, LAS float* scr, int lane) {
    const int nblk = N / 32, items = (K / 64) * nblk;
    if (r >= items) { r -= items; return false; }
    const int kb = r / nblk, nb = r % nblk, n0 = 32 * nb;
    const int drow0 = (mode == 0) ? n0 : (256 * (n0 >> 7) + (n0 & 127) + (mode == 2 ? 128 : 0));
    transpose_item(W, K, N, WT, scr, 64 * kb, n0, drow0, lane);
    return true;
}

__device__ __forceinline__ void convert_weights(KP pp, unsigned char* lds_g, int l, int widx, int nw, int lane, int wave) {
    LAS float* scr = (LAS float*)((LAS unsigned char*)lds_g + wave * 16384);
    constexpr int ITEMS_L = 13312;
    bf16* WB = (bf16*)(pp->ws + WS_W) + (size_t)l * LW_TOTAL;
    const size_t offf = (size_t)l * 1024 * 2816;
    for (int it = widx; it < ITEMS_L; it += nw) {
        int r = it;
        if (transpose_mat(r, pp->in[7] + offf, 1024, 2816, WB + LW_UP1, 1, scr, lane)) continue;
        if (transpose_mat(r, pp->in[8] + offf, 1024, 2816, WB + LW_UP1, 2, scr, lane)) continue;
        if (transpose_mat(r, pp->in[9] + offf, 2816, 1024, WB + LW_DN1, 0, scr, lane)) continue;
        if (transpose_mat(r, pp->in[10] + offf, 1024, 2816, WB + LW_UP2, 1, scr, lane)) continue;
        if (transpose_mat(r, pp->in[11] + offf, 1024, 2816, WB + LW_UP2, 2, scr, lane)) continue;
        if (transpose_mat(r, pp->in[12] + offf, 2816, 1024, WB + LW_DN2, 0, scr, lane)) continue;
        if (transpose_mat(r, pp->in[13] + (size_t)l * 1024 * INC, 1024, INC, WB + LW_WIN, 0, scr, lane)) continue;
        if (transpose_mat(r, pp->in[15] + (size_t)l * 262144, 256, 1024, WB + LW_AO, 0, scr, lane)) continue;
        if (transpose_mat(r, pp->in[18] + (size_t)l * 262144, 256, 1024, WB + LW_BO, 0, scr, lane)) continue;
        if (transpose_mat(r, pp->in[26] + (size_t)l * 262144, 256, 1024, WB + LW_DO, 0, scr, lane)) continue;
        if (transpose_mat(r, pp->in[21] + (size_t)l * 524288, 512, 1024, WB + LW_CO, 0, scr, lane)) continue;
        transpose_mat(r, pp->in[27] + (size_t)l * 1048576, 1024, 1024, WB + LW_O, 0, scr, lane);
    }
}

__device__ __forceinline__ void prologue(KP pp, unsigned char* lds_g, int tid, int lane, int wave, int vcu, int G) {
    LAS unsigned char* lds = (LAS unsigned char*)lds_g;
    convert_weights(pp, lds_g, 0, vcu * NWAVES + wave, G * NWAVES, lane, wave);
    __syncthreads();
    LAS float* sc = (LAS float*)lds;
    LAS float* part = (LAS float*)(lds + 32768);
    for (int i = tid; i < 5 * 1024; i += NTHR) { const int s = i >> 10, k = i & 1023; const float v = (s < 4) ? pp->in[1][s * 1024 + k] : pp->in[3][k]; sc[i] = fsilu(v); }
    __syncthreads();
    float* MOD = (float*)(pp->ws + WS_MOD);
    for (int it = vcu; it < 2 * 72; it += G) {
        const int l = it / 72, nb = it % 72; const int n = nb * 128 + 2 * lane;
        const float* wa = pp->in[4] + (size_t)l * 1024 * MODW + n;
        typedef float f32x2 __attribute__((ext_vector_type(2)));
        f32x2 a0 = {0.f, 0.f}, a1 = a0, a2 = a0, a3 = a0, a4 = a0;
#pragma unroll 8
        for (int kk = 0; kk < 128; ++kk) { const int k = wave * 128 + kk; const f32x2 w = *(const f32x2*)(wa + (size_t)k * MODW);
            a0 += w * sc[k]; a1 += w * sc[1024 + k]; a2 += w * sc[2048 + k]; a3 += w * sc[3072 + k]; a4 += w * sc[4096 + k]; }
        LAS f32x2* part2 = (LAS f32x2*)part;
        part2[(wave * 5 + 0) * 64 + lane] = a0; part2[(wave * 5 + 1) * 64 + lane] = a1; part2[(wave * 5 + 2) * 64 + lane] = a2; part2[(wave * 5 + 3) * 64 + lane] = a3; part2[(wave * 5 + 4) * 64 + lane] = a4;
        __syncthreads();
        if (tid < 320) { const int s = tid >> 6, cl = tid & 63; f32x2 v = *(const f32x2*)(pp->in[5] + l * MODW + nb * 128 + 2 * cl);
#pragma unroll
            for (int w = 0; w < 8; ++w) v += part2[(w * 5 + s) * 64 + cl];
            *(f32x2*)(MOD + ((size_t)l * 5 + s) * MODW + nb * 128 + 2 * cl) = v; }
        __syncthreads();
    }
    if (blockIdx.x == 0) {
        float* rc = (float*)(pp->ws + WS_ROPE); float* rs = rc + 1024;
        for (int i = tid; i < 1024; i += NTHR) { const int pos = i >> 4, f = i & 15;
            const float inv = exp2f(-(float)f * (13.287712379549449f / 16.0f));
            const float a = (float)pos * inv;
            const float kq = rintf(a * 0.15915494309189535f);
            float rr = fmaf(-kq, 6.2831854820251465f, a); rr = fmaf(-kq, -1.7484556000744883e-7f, rr);
            rc[i] = __cosf(rr); rs[i] = __sinf(rr); }
    }
    if (blockIdx.x == 1 && wave == 0) {
        float* LAM = (float*)(pp->ws + WS_LAM);
        for (int l = 0; l < 2; ++l) { const float* lp = pp->in[19] + l * 256;
            const float sa = wave_sum(lp[lane] * lp[64 + lane]), sb = wave_sum(lp[128 + lane] * lp[192 + lane]);
            int lo = l; float c08 = 0.8f, c06 = 0.6f, c1 = 1.0f; asm volatile("" : "+v"(lo), "+v"(c08), "+v"(c06), "+v"(c1)); const float lam_init = c08 - c06 * expf(-0.3f * (float)lo);
            if (lane == 0) { LAM[l * 2 + 0] = expf(sa) - expf(sb) + lam_init; asm volatile("" ::: "memory"); LAM[l * 2 + 1] = c1 - lam_init; } }
    }
}

__device__ __forceinline__ void norm_phase(KP pp, int l, int which, int lane, int gw, int NGW) {
    const int nrows = (l == 1 && which == 2) ? NX : MT;
    const bool first = (l == 0 && which == 0);
    const float* xs = first ? pp->in[0] : pp->out;
    const float* cs = (l == 0 && which <= 1) ? pp->in[2] : (const float*)(pp->ws + WS_CTX);
    const float* pgate = (const float*)(pp->ws + WS_MOD) + (size_t)((which == 0 ? l - 1 : l) * 5 + 4) * MODW + (which == 1 ? 2 : (which == 2 ? 5 : 8)) * 1024;
    const float pscale = (which == 2) ? 1.0f : 0.5f;
    const float* g = pp->in[6] + (l * 3 + which) * 1024; const float* MOD = (const float*)(pp->ws + WS_MOD) + (size_t)l * 5 * MODW;
    bf16* HN = (bf16*)(pp->ws + WS_HN);
    f32x4 gv[4];
#pragma unroll
    for (int j = 0; j < 4; ++j) gv[j] = *(const f32x4*)(g + 4 * lane + 256 * j);
    for (int blk = gw; blk * 8 < NX; blk += NGW) {
        const int r0 = blk * 8; const int set = r0 >> 12;
        const float* sh = MOD + (size_t)set * MODW + (3 * which) * 1024; const float* scl = sh + 1024;
        f32x4 gs[4], sv[4], cur[4], nxt[4];
#pragma unroll
        for (int j = 0; j < 4; ++j) { sv[j] = *(const f32x4*)(sh + 4 * lane + 256 * j); gs[j] = gv[j] * (*(const f32x4*)(scl + 4 * lane + 256 * j) + 1.0f); }
#pragma unroll
        for (int j = 0; j < 4; ++j) cur[j] = *(const f32x4*)(xs + (size_t)r0 * 1024 + 4 * lane + 256 * j);
#pragma unroll
        for (int i = 0; i < 8; ++i) {
            if (i < 7) {
#pragma unroll
                for (int j = 0; j < 4; ++j) nxt[j] = *(const f32x4*)(xs + (size_t)(r0 + i + 1) * 1024 + 4 * lane + 256 * j); }
            float s2 = 0.f;
#pragma unroll
            for (int j = 0; j < 4; ++j) s2 += (cur[j].x * cur[j].x + cur[j].y * cur[j].y) + (cur[j].z * cur[j].z + cur[j].w * cur[j].w);
            const float rstd = 1.0f / sqrtf(wave_sum(s2) * (1.0f / 1024.0f) + EPS);
#pragma unroll
            for (int j = 0; j < 4; ++j) { const f32x4 y = (cur[j] * rstd) * gs[j] + sv[j];
                u32x2 w; w.x = cvt_pk_bf16(y.x, y.y); w.y = cvt_pk_bf16(y.z, y.w);
                *(u32x2*)(HN + (size_t)(r0 + i) * 1024 + 4 * lane + 256 * j) = w; }
#pragma unroll
            for (int j = 0; j < 4; ++j) cur[j] = nxt[j];
        }
    }
    for (int r = NX + (NGW - 1 - gw); r < nrows; r += NGW) {
        const int set = 4;
        const float* xr = cs + (size_t)(r - NX) * 1024;
        const float* sh = MOD + (size_t)set * MODW + (3 * which) * 1024; const float* scl = sh + 1024;
        f32x4 v[4]; float s2 = 0.f;
#pragma unroll
        for (int j = 0; j < 4; ++j) v[j] = *(const f32x4*)(xr + 4 * lane + 256 * j);
        if (!first) {
            const float* PT = (const float*)(pp->ws + WS_PART) + (size_t)(r - NX) * 1024; float* cw = (float*)(pp->ws + WS_CTX) + (size_t)(r - NX) * 1024;
#pragma unroll
            for (int j = 0; j < 4; ++j) { const int o = 4 * lane + 256 * j;
                f32x4 ps = (*(const f32x4*)(PT + o) + *(const f32x4*)(PT + 1048576 + o)) + (*(const f32x4*)(PT + 2097152 + o) + *(const f32x4*)(PT + 3145728 + o));
                ps = ps + ((*(const f32x4*)(PT + 4194304 + o) + *(const f32x4*)(PT + 5242880 + o)) + (*(const f32x4*)(PT + 6291456 + o) + *(const f32x4*)(PT + 7340032 + o)));
                v[j] = v[j] + *(const f32x4*)(pgate + o) * pscale * ps; *(f32x4*)(cw + o) = v[j]; }
        }
#pragma unroll
        for (int j = 0; j < 4; ++j) s2 += (v[j].x * v[j].x + v[j].y * v[j].y) + (v[j].z * v[j].z + v[j].w * v[j].w);
        const float rstd = 1.0f / sqrtf(wave_sum(s2) * (1.0f / 1024.0f) + EPS);
#pragma unroll
        for (int j = 0; j < 4; ++j) { const f32x4 s = *(const f32x4*)(sh + 4 * lane + 256 * j), cc = *(const f32x4*)(scl + 4 * lane + 256 * j);
            const f32x4 y = (v[j] * rstd) * gv[j] * (cc + 1.0f) + s;
            u32x2 w; w.x = cvt_pk_bf16(y.x, y.y); w.y = cvt_pk_bf16(y.z, y.w);
            *(u32x2*)(HN + (size_t)r * 1024 + 4 * lane + 256 * j) = w; }
    }
}
__device__ __forceinline__ void final_norm(KP pp, int lane, int gw, int NGW) {
    const float* g = pp->in[28];
    f32x4 gg[4];
#pragma unroll
    for (int j = 0; j < 4; ++j) gg[j] = *(const f32x4*)(g + 4 * lane + 256 * j);
    for (int blk = gw; blk * 8 < NX; blk += NGW) { float* x0 = pp->out + (size_t)blk * 8 * 1024;
        f32x4 cur[4], nxt[4];
#pragma unroll
        for (int j = 0; j < 4; ++j) cur[j] = *(const f32x4*)(x0 + 4 * lane + 256 * j);
#pragma unroll
        for (int i = 0; i < 8; ++i) {
            if (i < 7) {
#pragma unroll
                for (int j = 0; j < 4; ++j) nxt[j] = *(const f32x4*)(x0 + (size_t)(i + 1) * 1024 + 4 * lane + 256 * j); }
            float s2 = 0.f;
#pragma unroll
            for (int j = 0; j < 4; ++j) s2 += (cur[j].x * cur[j].x + cur[j].y * cur[j].y) + (cur[j].z * cur[j].z + cur[j].w * cur[j].w);
            const float rstd = 1.0f / sqrtf(wave_sum(s2) * (1.0f / 1024.0f) + EPS);
#pragma unroll
            for (int j = 0; j < 4; ++j) *(f32x4*)(x0 + (size_t)i * 1024 + 4 * lane + 256 * j) = (cur[j] * rstd) * gg[j];
#pragma unroll
            for (int j = 0; j < 4; ++j) cur[j] = nxt[j];
        }
    }
}

__device__ __forceinline__ void unpack8(const u32x4 w, float* f) { f[0] = bf_lo(w.x); f[1] = bf_hi(w.x); f[2] = bf_lo(w.y); f[3] = bf_hi(w.y); f[4] = bf_lo(w.z); f[5] = bf_hi(w.z); f[6] = bf_lo(w.w); f[7] = bf_hi(w.w); }
__device__ __forceinline__ u32x4 pack8(const float* f) { u32x4 w; w.x = cvt_pk_bf16(f[0], f[1]); w.y = cvt_pk_bf16(f[2], f[3]); w.z = cvt_pk_bf16(f[4], f[5]); w.w = cvt_pk_bf16(f[6], f[7]); return w; }
__device__ __forceinline__ void batch_bounds(int r, int& b0, int& b1) { if (r < NX) { b0 = r & ~(SEQ - 1); b1 = b0 + SEQ; } else { b0 = NX + ((r - NX) & ~(CTXL - 1)); b1 = b0 + CTXL; } }

__device__ __forceinline__ void branch_a(KP pp, int l, int nrows, int gtid, int ngt) {
    bf16* PX = (bf16*)(pp->ws + WS_PX); const float* cw = pp->in[14] + l * 768;
    for (int it = gtid; it < nrows * 32; it += ngt) {
        const int r = it >> 5, c0 = (it & 31) * 8; int b0, b1; batch_bounds(r, b0, b1);
        float acc[8];
#pragma unroll
        for (int i = 0; i < 8; ++i) acc[i] = 0.f;
#pragma unroll
        for (int k = 0; k < 3; ++k) { const int rr = r + k - 1;
            if (rr >= b0 && rr < b1) { float cg[8], xi[8]; unpack8(*(const u32x4*)(PX + (size_t)rr * PXW + 256 + c0), cg); unpack8(*(const u32x4*)(PX + (size_t)rr * PXW + 512 + c0), xi);
                const f32x4 w0 = *(const f32x4*)(cw + k * 256 + c0), w1 = *(const f32x4*)(cw + k * 256 + c0 + 4);
                acc[0] += w0.x * cg[0] * xi[0]; acc[1] += w0.y * cg[1] * xi[1]; acc[2] += w0.z * cg[2] * xi[2]; acc[3] += w0.w * cg[3] * xi[3];
                acc[4] += w1.x * cg[4] * xi[4]; acc[5] += w1.y * cg[5] * xi[5]; acc[6] += w1.z * cg[6] * xi[6]; acc[7] += w1.w * cg[7] * xi[7]; } }
        float bg[8]; unpack8(*(const u32x4*)(PX + (size_t)r * PXW + c0), bg);
#pragma unroll
        for (int i = 0; i < 8; ++i) acc[i] *= bg[i];
        *(u32x4*)(PX + (size_t)r * PXW + c0) = pack8(acc);
    }
}

__device__ __forceinline__ void branch_b(KP pp, int l, int nrows, unsigned char* lds_g, int tid, int vcu, int G) {
    bf16* PX = (bf16*)(pp->ws + WS_PX); LAS unsigned short* vt = (LAS unsigned short*)lds_g;
    const int lane = tid & 63, wave = tid >> 6, quad = lane >> 4, l15 = lane & 15;
    const int nunits = (nrows / 128) * 4;
    for (int ut = G - 1 - vcu; ut < nunits; ut += G) {
        const int ch = ut >> 2, g = ut & 3; const int q = tid >> 2, part = tid & 3;
        const bf16* vr = PX + (size_t)(ch * 128 + q) * PXW + 1024;
        float s1 = 0.f, s2 = 0.f;
#pragma unroll
        for (int j = 0; j < 8; ++j) { float f[8]; unpack8(*(const u32x4*)(vr + part * 64 + j * 8), f);
#pragma unroll
            for (int i = 0; i < 8; ++i) { s1 += f[i]; s2 += f[i] * f[i]; } }
        s1 += __shfl_xor(s1, 1); s1 += __shfl_xor(s1, 2); s2 += __shfl_xor(s2, 1); s2 += __shfl_xor(s2, 2);
        const float mean = s1 * (1.0f / 256.0f); const float var = fmaxf(s2 * (1.0f / 256.0f) - mean * mean, 0.f); const float rstd = 1.0f / sqrtf(var + EPS);
#pragma unroll
        for (int j = 0; j < 2; ++j) { float f[8]; unpack8(*(const u32x4*)(vr + g * 64 + part * 16 + j * 8), f);
#pragma unroll
            for (int i = 0; i < 8; i += 2) { const unsigned w = cvt_pk_bf16((f[i] - mean) * rstd, (f[i + 1] - mean) * rstd);
                vt[(part * 16 + j * 8 + i) * 136 + q] = (unsigned short)(w & 0xffffu); vt[(part * 16 + j * 8 + i + 1) * 136 + q] = (unsigned short)(w >> 16); } }
        __syncthreads();
        f32x4 acc[4];
#pragma unroll
        for (int nt = 0; nt < 4; ++nt) acc[nt] = (f32x4){0.f, 0.f, 0.f, 0.f};
        const float* wrow = pp->in[16] + ((size_t)(l * 4 + g) * 128 + 16 * wave + l15) * 128 + 8 * quad;
#pragma unroll
        for (int ks = 0; ks < 4; ++ks) {
            const f32x4 w0 = *(const f32x4*)(wrow + 32 * ks), w1 = *(const f32x4*)(wrow + 32 * ks + 4);
            u32x4 aw; aw.x = cvt_pk_bf16(w0.x, w0.y); aw.y = cvt_pk_bf16(w0.z, w0.w); aw.z = cvt_pk_bf16(w1.x, w1.y); aw.w = cvt_pk_bf16(w1.z, w1.w);
            const pg8::bf16x8 a = __builtin_bit_cast(pg8::bf16x8, aw);
#pragma unroll
            for (int nt = 0; nt < 4; ++nt) { const pg8::bf16x8 b = *(const LAS pg8::bf16x8*)(vt + (16 * nt + l15) * 136 + 32 * ks + 8 * quad);
                acc[nt] = __builtin_amdgcn_mfma_f32_16x16x32_bf16(a, b, acc[nt], 0, 0, 0); }
        }
#pragma unroll
        for (int i = 0; i < 4; ++i) { const int p = 16 * wave + quad * 4 + i; const float bias = pp->in[17][(l * 4 + g) * 128 + p];
            bf16* up = PX + (size_t)(ch * 128 + p) * PXW + 768 + g * 64 + l15;
#pragma unroll
            for (int nt = 0; nt < 4; ++nt) { const float uv = __uint_as_float((unsigned)up[16 * nt] << 16); up[16 * nt] = (bf16)(cvt_pk_bf16(uv * (acc[nt][i] + bias), 0.f) & 0xffffu); } }
        __syncthreads();
    }
}

__device__ __forceinline__ void branch_d(KP pp, int l, int nrows, unsigned char* lds_g, int tid, int lane, int wave, int vcu, int G) {
    const bf16* PX = (const bf16*)(pp->ws + WS_PX); bf16* AD = (bf16*)(pp->ws + WS_ACTD);
    LAS float* hs = (LAS float*)lds_g;
    LAS float* cv = (LAS float*)(lds_g + 65536);
    const float* dw = pp->in[22] + l * 31 * 256; const float* db = pp->in[23] + l * 256; const float* lg = pp->in[24] + l * 256; const float* lb = pp->in[25] + l * 256;
    const int nunits = nrows / 32;
    for (int ut = G - 1 - vcu; ut < nunits; ut += G) {
        const int R0 = ut * 32; int b0, b1; batch_bounds(R0, b0, b1);
        for (int it = tid; it < 62 * 32; it += NTHR) { const int rr = it >> 5, c0 = (it & 31) * 8; const int r = R0 - 15 + rr;
            float h[8];
            if (r >= b0 && r < b1) { float z0[8], z1[8]; unpack8(*(const u32x4*)(PX + (size_t)r * PXW + D_OFF + c0), z0); unpack8(*(const u32x4*)(PX + (size_t)r * PXW + D_OFF + 256 + c0), z1);
#pragma unroll
                for (int i = 0; i < 8; ++i) h[i] = z0[i] * fsigmoid(z1[i]); }
            else {
#pragma unroll
                for (int i = 0; i < 8; ++i) h[i] = 0.f; }
            *(LAS f32x4*)(hs + rr * 256 + c0) = (f32x4){h[0], h[1], h[2], h[3]}; *(LAS f32x4*)(hs + rr * 256 + c0 + 4) = (f32x4){h[4], h[5], h[6], h[7]}; }
        __syncthreads();
        { const int c = tid & 255, half = tid >> 8; const float bias = db[c];
            float o[16];
#pragma unroll
            for (int i = 0; i < 16; ++i) o[i] = bias;
#pragma unroll
            for (int k = 0; k < 31; ++k) { const float w = dw[k * 256 + c];
#pragma unroll
                for (int i = 0; i < 16; ++i) o[i] += w * hs[(half * 16 + i + k) * 256 + c]; }
#pragma unroll
            for (int i = 0; i < 16; ++i) cv[(half * 16 + i) * 256 + c] = o[i]; }
        __syncthreads();
#pragma unroll
        for (int i = 0; i < 4; ++i) { const int rr = wave * 4 + i; const f32x4 v = *(const LAS f32x4*)(cv + rr * 256 + 4 * lane);
            const float mean = wave_sum((v.x + v.y) + (v.z + v.w)) * (1.0f / 256.0f); const f32x4 d = v - mean;
            const float var = wave_sum((d.x * d.x + d.y * d.y) + (d.z * d.z + d.w * d.w)) * (1.0f / 256.0f); const float rstd = 1.0f / sqrtf(var + EPS);
            const f32x4 gg = *(const f32x4*)(lg + 4 * lane), bb = *(const f32x4*)(lb + 4 * lane); const f32x4 y = d * rstd * gg + bb;
            u32x2 w; w.x = cvt_pk_bf16(fsilu(y.x), fsilu(y.y)); w.y = cvt_pk_bf16(fsilu(y.z), fsilu(y.w));
            *(u32x2*)(AD + (size_t)(R0 + rr) * 256 + 4 * lane) = w; }
        __syncthreads();
    }
}

__device__ __forceinline__ void act_c(KP pp, int l, int r0, int h, int tid) {
    const bf16* OB = (const bf16*)(pp->ws + WS_OB); bf16* PX = (bf16*)(pp->ws + WS_PX); const float* LAM = (const float*)(pp->ws + WS_LAM) + l * 2;
    const float lam = LAM[0], oml = LAM[1]; const float* sg = pp->in[20] + l * 128;
    const int sub = tid & 15; f32x4 g0 = *(const f32x4*)(sg + sub * 8), g1 = *(const f32x4*)(sg + sub * 8 + 4);
#pragma unroll
    for (int it = 0; it < 8; ++it) { const int r = r0 + it * 32 + (tid >> 4);
        float a[8], b[8], o[8]; unpack8(*(const u32x4*)(OB + (size_t)r * 1024 + h * 256 + sub * 8), a); unpack8(*(const u32x4*)(OB + (size_t)r * 1024 + h * 256 + 128 + sub * 8), b);
        float s2 = 0.f;
#pragma unroll
        for (int i = 0; i < 8; ++i) { o[i] = a[i] - lam * b[i]; s2 += o[i] * o[i]; }
        s2 += __shfl_xor(s2, 1); s2 += __shfl_xor(s2, 2); s2 += __shfl_xor(s2, 4); s2 += __shfl_xor(s2, 8);
        const float rs = oml / sqrtf(s2 * (1.0f / 128.0f) + EPS);
        o[0] *= rs * g0.x; o[1] *= rs * g0.y; o[2] *= rs * g0.z; o[3] *= rs * g0.w; o[4] *= rs * g1.x; o[5] *= rs * g1.y; o[6] *= rs * g1.z; o[7] *= rs * g1.w;
        *(u32x4*)(PX + (size_t)r * PXW + Q_OFF + h * 128 + sub * 8) = pack8(o); }
}

__device__ __forceinline__ void attn_mix_phase(KP pp, int l, unsigned char* lds_g, int tid, int lane, int wave, int vcu, int G) {
    using abf = attn_body::bf16;
    const abf* PX = (const abf*)(pp->ws + WS_PX); abf* OB = (abf*)(pp->ws + WS_OB);
    const int njobs = 256 + ((l == 0) ? 16 : 0);
    for (int j = vcu; j < njobs; j += G) {
        int b, h, r0, krow0, ntm, krow1, NT;
        if (j < 256) { const int bh = j >> 4, qb = j & 15; b = bh >> 2; h = bh & 3; r0 = b * SEQ + qb * 256; krow0 = b * SEQ; ntm = 64; krow1 = NX + b * CTXL; NT = 68; }
        else { const int w = j - 256; b = w >> 2; h = w & 3; r0 = NX + b * CTXL; krow0 = r0; ntm = 4; krow1 = r0; NT = 4; }
#pragma unroll 1
        for (int me_ = 0; me_ < 2 * MK_REP_ATTN; ++me_) { const int m = me_ & 1;
            attn_body::attn_unit2<8>(PX + (size_t)r0 * PXW + Q_OFF + h * 128 + m * 64, PX + K_OFF + h * 128 + m * 64, PX + V_OFF + h * 128,
                                     OB + (size_t)r0 * 1024 + h * 256 + m * 128, krow0, ntm, krow1, NT, (char*)lds_g); }
        __threadfence(); __syncthreads(); __builtin_amdgcn_fence(__ATOMIC_ACQUIRE, "agent");
        act_c(pp, l, r0, h, tid);
        __syncthreads();
    }
    const int nrows = (l == 0) ? MT : NX;
    branch_a(pp, l, nrows, vcu * NTHR + tid, G * NTHR);
    branch_b(pp, l, nrows, lds_g, tid, vcu, G);
    branch_d(pp, l, nrows, lds_g, tid, lane, wave, vcu, G);
}

__global__ void __launch_bounds__(NTHR, 2) mega_fwd(Params p) {
    extern __shared__ __attribute__((aligned(16))) unsigned char lds[];
    cg::grid_group grid = cg::this_grid();
    KP pk = (KP)__builtin_amdgcn_kernarg_segment_ptr();
    const int ph_lo = pk->ph_lo, ph_hi = pk->ph_hi;
    volatile LAS unsigned* bst = (volatile LAS unsigned*)((LAS unsigned char*)lds + 131072 + 64);
    if (threadIdx.x < 2) bst[threadIdx.x] = 0u;
    __syncthreads();
    XcdBarrier xbar = xcd_barrier_post((unsigned*)(pk->ws + WS_BAR), bst);
    for (int pi = ph_lo; pi < ph_hi; ++pi) {
        const int ph = (MK_REP_PH >= 0 && pi > MK_REP_PH) ? pi - 1 : pi;
        KP pp = pk; asm volatile("" : "+s"(pp));
        const int tid = tid_now(), lane = tid & 63, wave = __builtin_amdgcn_readfirstlane(tid >> 6);
        const int G = gridDim.x; int bx = blockIdx.x; asm volatile("" : "+s"(bx)); const int vcu = (G % 8 == 0) ? (bx % 8) * (G / 8) + bx / 8 : bx;
        const int gw = vcu * NWAVES + wave, NGW = G * NWAVES;
        pg8::LdsPtr ldsp = (pg8::LdsPtr)lds;
        if (ph == 0) prologue(pp, lds, tid, lane, wave, vcu, G);
        else if (ph == 23) final_norm(pp, lane, gw, NGW);
        else {
            const int l = (ph - 1) / 11, s = (ph - 1) % 11;
            bf16* HN = (bf16*)(pp->ws + WS_HN); bf16* PX = (bf16*)(pp->ws + WS_PX); bf16* MG = (bf16*)(pp->ws + WS_OB);
            const bf16* WB = (const bf16*)(pp->ws + WS_W) + (size_t)l * LW_TOTAL;
            if (s == 0 || s == 3 || s == 8) norm_phase(pp, l, s == 0 ? 0 : (s == 3 ? 1 : 2), lane, gw, NGW);
            else if (s == 1 || s == 9) {
                const int Mrows = (l == 1 && s == 9) ? NX : MT;
                pg8::Gemm g{HN, WB + (s == 1 ? LW_UP1 : LW_UP2), 1024, 1024, 1024}; pg8::StaticOrder S; S.init(Mrows, 5632, G, bx);
                pg8::EpiSwiGLU E{PX};
                pg8::gemm_phase<pg8::EpiSwiGLU, pg8::StaticOrder, true, true>(ldsp, g, S, E);
            } else if (s == 2 || s == 7 || s == 10) {
                const bool first = (l == 0 && s == 2); const bool ctxrows = !(l == 1 && s != 2);
                float* CTX = (float*)(pp->ws + WS_CTX); const float* MOD = (const float*)(pp->ws + WS_MOD) + (size_t)l * 5 * MODW;
                const bf16* A = (s == 7) ? MG : PX; const int lda = (s == 7) ? 1024 : FF; const int K = lda;
                const bf16* W = WB + (s == 2 ? LW_DN1 : (s == 7 ? LW_O : LW_DN2));
                { pg8::Gemm g{A, W, lda, K, K}; pg8::StaticOrder S; S.init(NX, 1024, G, bx);
                  pg8::EpiRes E{first ? pp->in[0] : pp->out, CTX, pp->out, CTX, MOD + (s == 2 ? 2 : (s == 7 ? 5 : 8)) * 1024, (s == 7) ? 1.0f : 0.5f};
                  pg8::gemm_phase<pg8::EpiRes, pg8::StaticOrder, true, true>(ldsp, g, S, E); }
                if (ctxrows && (bx & 1) == 1) {
                    KP pq = pk; asm volatile("" : "+s"(pq));
                    const int j = bx >> 1, ut = j >> 3, sp = j & 7;
                    pg8::OneUnit S1{pg8::Unit{64 + (ut >> 2), ut & 3}};
                    const bf16* WB2 = (const bf16*)(pq->ws + WS_W) + (size_t)l * LW_TOTAL; float* PT = (float*)(pq->ws + WS_PART) + (size_t)sp * 1048576;
                    const bf16* A2; const bf16* W2; int ld2, kc;
                    if (s == 7) { const int kh = (sp & 1) * 512;
                        A2 = (const bf16*)(pq->ws + WS_MGP) + (size_t)(sp >> 1) * 1048576 - (size_t)NX * 1024 + kh; W2 = WB2 + LW_O + kh; ld2 = 1024; kc = 512;
                    } else { const int k0 = (sp < 6) ? sp * 384 : 2304 + (sp - 6) * 256;
                        A2 = (const bf16*)(pq->ws + WS_PX) + k0; W2 = WB2 + (s == 2 ? LW_DN1 : LW_DN2) + k0; ld2 = FF; kc = (sp < 6) ? 384 : 256; }
                    pg8::Gemm g{A2, W2, ld2, ld2, kc}; pg8::EpiPart E{PT};
                    pg8::gemm_phase<pg8::EpiPart, pg8::OneUnit, true, true>(ldsp, g, S1, E);
                }
            } else if (s == 4) {
                pg8::Gemm g{HN, WB + LW_WIN, 1024, 1024, 1024}; pg8::StaticOrder S; S.init(MT, PXW, G, bx);
                pg8::EpiWin E{PX, (const float*)(pp->ws + WS_ROPE), (const float*)(pp->ws + WS_ROPE) + 1024, C2};
                pg8::gemm_phase<pg8::EpiWin, pg8::StaticOrder, true, true>(ldsp, g, S, E);
            } else if (s == 5) attn_mix_phase(pp, l, lds, tid, lane, wave, vcu, G);
            else if (s == 6) {
                const int nctx = (l == 0 && (bx & 3) == 1) ? 1 : 0;
                pg8::StaticOrder S; S.init(NX, 1024, G, bx); pg8::Unit u;
                for (int i = 0; i < 1 + nctx; ++i) {
                    int br_lo = 0, br_hi = 4;
                    if (i == 0) { if (!S.next(0, u)) continue; }
                    else { const int j = bx >> 2, ut = j >> 2; u.pm = 64 + (ut >> 2); u.pn = ut & 3; br_lo = j & 3; br_hi = br_lo + 1; }
#pragma unroll 1
                    for (int br = br_lo; br < br_hi; ++br) {
                        if (!((MK_BRMASK >> br) & 1)) continue;
                        KP pq = pk; asm volatile("" : "+s"(pq));
                        bf16* GSw = (bf16*)(pq->ws + WS_GS) + (size_t)bx * 65536; const bf16* HN2 = (const bf16*)(pq->ws + WS_HN);
                        const bf16* WB2 = (const bf16*)(pq->ws + WS_W) + (size_t)l * LW_TOTAL;
                        pg8::OneUnit S1{u};
                        { pg8::Gemm g{HN2, WB2 + LW_WIN + (size_t)(G_OFF + br * 1024) * 1024, 1024, 1024, 1024}; pg8::EpiGate E{GSw};
                          pg8::gemm_phase<pg8::EpiGate, pg8::OneUnit, true, true>(ldsp, g, S1, E); }
                        const bf16* PX2 = (const bf16*)(pq->ws + WS_PX);
                        const bf16* A = (br == 0) ? PX2 + A_OFF : (br == 1) ? PX2 + B_OFF : (br == 2) ? PX2 + Q_OFF : (const bf16*)(pq->ws + WS_ACTD);
                        const int lda = (br == 3) ? 256 : PXW; const int K = (br == 2) ? 512 : 256;
                        const bf16* W = WB2 + ((br == 0) ? LW_AO : (br == 1) ? LW_BO : (br == 2) ? LW_CO : LW_DO);
                        bf16* MGd = (i == 0) ? (bf16*)(pq->ws + WS_OB) : (bf16*)(pq->ws + WS_MGP) + (size_t)br * 1048576 - (size_t)NX * 1024;
                        { pg8::Gemm g{A, W, lda, K, K}; pg8::EpiBranch E{GSw, MGd, (i == 0) ? ((MK_BRMASK & ((1 << br) - 1)) == 0) : 1};
                          pg8::gemm_phase<pg8::EpiBranch, pg8::OneUnit, true, true>(ldsp, g, S1, E); }
                    }
                }
                if (l == 0 && (bx & 3) != 1) {
                    KP pq = pk; asm volatile("" : "+s"(pq));
                    convert_weights(pq, lds, 1, (bx - ((bx + 2) >> 2)) * NWAVES + wave, (G - G / 4) * NWAVES, lane, wave);
                }
            }
        }
        if (pi + 1 < ph_hi) {
            if (ph_hi > 4096) grid.sync();
            xcd_barrier(xbar);
        }
    }
}


extern "C" void kernel_launch(void* const* d_in, const int* in_sizes, int n_in, void* d_out, int out_size, void* d_ws, size_t ws_size, hipStream_t stream) {
    static int grid = 0;
    if (grid == 0) {
        if (n_in != 29 || out_size != NX * 1024 || ws_size < WS_END) { fprintf(stderr, "kernel_launch: unexpected shapes / workspace (n_in %d out %d ws %zu)\n", n_in, out_size, ws_size); grid = -1; return; }
        int dev = 0, cus = 0, per_cu = 0;
        if (hipGetDevice(&dev) != hipSuccess || hipDeviceGetAttribute(&cus, hipDeviceAttributeMultiprocessorCount, dev) != hipSuccess) { grid = -1; return; }
        if (hipFuncSetAttribute((const void*)mega_fwd, hipFuncAttributeMaxDynamicSharedMemorySize, LDS_BYTES) != hipSuccess) { fprintf(stderr, "kernel_launch: hipFuncSetAttribute failed\n"); grid = -1; return; }
        if (hipOccupancyMaxActiveBlocksPerMultiprocessor(&per_cu, (const void*)mega_fwd, NTHR, LDS_BYTES) != hipSuccess || per_cu < 1) { fprintf(stderr, "kernel_launch: occupancy query says %d\n", per_cu); per_cu = 1; }
        (void)hipGetLastError();
        grid = cus;
    }
    if (grid < 0) return;
    if (hipMemsetAsync((char*)d_ws + WS_BAR, 0, 16384, stream) != hipSuccess) { fprintf(stderr, "kernel_launch: memset failed\n"); return; }
    Params p{};
    for (int i = 0; i < 29; ++i) p.in[i] = (const float*)d_in[i];
    p.out = (float*)d_out; p.ws = (unsigned char*)d_ws;
#if MK_PER_PHASE
    for (int ph = 0; ph < 24; ++ph) { if (ph >= MK_NPH && ph != 23) continue; p.ph_lo = ph; p.ph_hi = ph + 1; hipLaunchKernelGGL(mega_fwd, dim3(grid), dim3(NTHR), LDS_BYTES, stream, p); }
#else
    p.ph_lo = 0; p.ph_hi = 24 + ((MK_REP_PH >= 0) ? 1 : 0);
    void* args[] = {&p};
    hipError_t e = hipLaunchCooperativeKernel((const void*)mega_fwd, dim3(grid), dim3(NTHR), args, LDS_BYTES, stream);
    if (e != hipSuccess) fprintf(stderr, "cooperative launch failed: %s (grid %d)\n", hipGetErrorString(e), grid);
#endif
}
```

```cpp
#include <hip/hip_runtime.h>
#include <hip/hip_cooperative_groups.h>
#include <hip/hip_bf16.h>
#include <cstdio>
#include <cstdint>
#include <cmath>
namespace cg = cooperative_groups;
__device__ __forceinline__ int tid_now() { int t = threadIdx.x; asm volatile("" : "+v"(t)); return t; }
#ifndef MK_PER_PHASE
#define MK_PER_PHASE 0
#endif
#ifndef MK_NPH
#define MK_NPH 24
#endif
#ifndef MK_BRMASK
#define MK_BRMASK 15
#endif
#ifndef MK_REP_PH
#define MK_REP_PH -1
#endif
#ifndef MK_REP_ATTN
#define MK_REP_ATTN 1
#endif
namespace pg8 {
#define PG8_LAS __attribute__((address_space(3)))
typedef unsigned short bf16_t;
typedef short bf16x8 __attribute__((ext_vector_type(8)));
typedef float f32x4 __attribute__((ext_vector_type(4)));
typedef unsigned u32x4 __attribute__((ext_vector_type(4)));
typedef PG8_LAS unsigned char* LdsPtr;
constexpr int BM = 256, BK = 64, HALF = 128, HTB = HALF * BK * 2  , STAGE_BYTES = 8 * HTB, NXCD = 8, WGM = 8;

__host__ __device__ __forceinline__ int lds_byte(int r, int c) { const int st = (r >> 4) * 2 + (c >> 5), rr = r & 15, cc = c & 31, ob = rr * 64 + cc * 2; return st * 1024 + (ob ^ (((ob >> 9) & 1) << 5)); }
__host__ __device__ __forceinline__ void stage_rc(int b, int& R, int& C) { const int st = b / 1024, sb = b % 1024, swz = sb ^ (((sb >> 9) & 1) << 5); R = (st >> 1) * 16 + swz / 64; C = (st & 1) * 32 + (swz % 64) / 2; }
__host__ __device__ __forceinline__ int perm32(int rho) { const int n = rho >> 4, i = rho & 15; return 8 * (i >> 2) + 4 * n + (i & 3); }

struct Unit { int pm, pn; };
struct Gemm { const bf16_t* A; const bf16_t* Bt; int lda, ldb, K; };

struct StaticOrder {
    int nM, nN, nwg, G, c;
    __host__ __device__ void init(int M, int N, int G_, int c_) { nM = M / BM; nN = N / BM; nwg = nM * nN; G = G_; c = c_; }
    __host__ __device__ bool next(int i, Unit& u) const {
        const long L = (long)i * G + c; if (L >= nwg) return false;
        int wgid = (int)L; { const int q = nwg / NXCD, r = nwg % NXCD, xcd = wgid % NXCD, off = wgid / NXCD; wgid = (xcd < r ? xcd * (q + 1) : r * (q + 1) + (xcd - r) * q) + off; }
        const int nig = WGM * nN, gid = wgid / nig, fm = gid * WGM, gsz = (nM - fm) < WGM ? (nM - fm) : WGM;
        u.pm = fm + ((wgid % nig) % gsz); u.pn = (wgid % nig) / gsz; return true;
    }
    __device__ __forceinline__ void a_ready(const Unit&) const {}
    __device__ __forceinline__ void done(const Unit&) const {}
};


struct OneUnit {
    Unit u;
    __device__ __forceinline__ bool next(int i, Unit& o) const { if (i) return false; o = u; return true; }
    __device__ __forceinline__ void a_ready(const Unit&) const {}
    __device__ __forceinline__ void done(const Unit&) const {}
};

typedef float f32x2_cv __attribute__((ext_vector_type(2))); typedef __bf16 bf16x2_cv __attribute__((ext_vector_type(2)));
__device__ __forceinline__ unsigned cvt_pk_bf16(float lo, float hi) { f32x2_cv v = {lo, hi}; bf16x2_cv b = __builtin_convertvector(v, bf16x2_cv); return __builtin_bit_cast(unsigned, b); }
typedef unsigned u32x2 __attribute__((ext_vector_type(2)));
__device__ __forceinline__ float fsigmoid(float v) { return __builtin_amdgcn_rcpf(1.0f + __builtin_amdgcn_exp2f(-1.4426950408889634f * v)); }
__device__ __forceinline__ float fsilu(float v) { return v * fsigmoid(v); }
__device__ __forceinline__ float ftanh(float v) { return 2.0f * fsigmoid(2.0f * v) - 1.0f; }
__device__ __forceinline__ float fgelu_tanh(float v) { const float u = 0.7978845608028654f * (v + 0.044715f * v * v * v); return v * fsigmoid(2.0f * u); }
__device__ __forceinline__ float bf_lo(unsigned w) { return __uint_as_float(w << 16); }
__device__ __forceinline__ float bf_hi(unsigned w) { return __uint_as_float(w & 0xffff0000u); }

constexpr int ROWS_X = 16384, PXW = 3328, DFF = 2816, MODW = 9216;

struct EpiSwiGLU {
    static constexpr bool PERM = true, AFTER_DRAIN = false;
    bf16_t* H;
    __device__ __forceinline__ void operator()(const f32x4 (&acc)[2][2][4][2], const Unit& u, int wr, int wc, int fr, int fq) const {
        const int row0 = u.pm * BM + wr * 64 + fr, col0 = u.pn * HALF + wc * 32 + 8 * fq;
#pragma unroll
        for (int ai = 0; ai < 2; ++ai)
#pragma unroll
            for (int m = 0; m < 4; ++m) {
                bf16_t* rowp = H + (size_t)(row0 + ai * HALF + m * 16) * DFF + col0;
                const f32x4 a0 = acc[ai][0][m][0], a1 = acc[ai][0][m][1], b0 = acc[ai][1][m][0], b1 = acc[ai][1][m][1];
                u32x4 w;
                w.x = cvt_pk_bf16(fsilu(a0[0]) * b0[0], fsilu(a0[1]) * b0[1]); w.y = cvt_pk_bf16(fsilu(a0[2]) * b0[2], fsilu(a0[3]) * b0[3]);
                w.z = cvt_pk_bf16(fsilu(a1[0]) * b1[0], fsilu(a1[1]) * b1[1]); w.w = cvt_pk_bf16(fsilu(a1[2]) * b1[2], fsilu(a1[3]) * b1[3]);
                *(u32x4*)rowp = w;
            }
    }
};

struct EpiRes {
    static constexpr bool PERM = false, AFTER_DRAIN = false;
    const float* bx; const float* bc; float* ox; float* oc; const float* gate; float sc;
    __device__ __forceinline__ void operator()(const f32x4 (&acc)[2][2][4][2], const Unit& u, int wr, int wc, int fr, int fq) const {
        const bool isx = u.pm < 64; const int set = isx ? (u.pm >> 4) : 4;
        const size_t roff = (size_t)(isx ? u.pm : u.pm - 64) * BM * 1024;
        const float* base = (isx ? bx : bc) + roff; float* out = (isx ? ox : oc) + roff;
        const int col0 = u.pn * BM + wc * 32 + 4 * fq; const float* gp = gate + (size_t)set * MODW + col0;
        f32x4 gv[2][2];
#pragma unroll
        for (int bj = 0; bj < 2; ++bj)
#pragma unroll
            for (int n = 0; n < 2; ++n) gv[bj][n] = *(const f32x4*)(gp + bj * HALF + n * 16) * sc;
#pragma unroll
        for (int ai = 0; ai < 2; ++ai)
#pragma unroll
            for (int m = 0; m < 4; ++m) {
                const size_t off = (size_t)(ai * HALF + wr * 64 + m * 16 + fr) * 1024 + col0;
#pragma unroll
                for (int bj = 0; bj < 2; ++bj)
#pragma unroll
                    for (int n = 0; n < 2; ++n) {
                        const f32x4 b = *(const f32x4*)(base + off + bj * HALF + n * 16);
                        *(f32x4*)(out + off + bj * HALF + n * 16) = b + gv[bj][n] * acc[ai][bj][m][n];
                    }
            }
    }
};

__device__ __forceinline__ float lane32_partner(float x, bool hi) { auto rr = __builtin_amdgcn_permlane32_swap(__float_as_uint(x), __float_as_uint(x), false, false); return __uint_as_float(hi ? rr[0] : rr[1]); }
struct EpiWin {
    static constexpr bool PERM = true, AFTER_DRAIN = false;
    bf16_t* PX; const float* rcos; const float* rsin; float qscale;
    __device__ __forceinline__ void operator()(const f32x4 (&acc)[2][2][4][2], const Unit& u, int wr, int wc, int fr, int fq) const {
        const int pn = u.pn; const bool isx = u.pm < 64;
        const bool gel = (pn == 3 || pn == 4), isq = (pn == 5 || pn == 6), rope = (pn >= 5 && pn <= 8) && isx;
        const float sc = isq ? qscale : 1.0f; const bool hi = fq >= 2; const float sgn = hi ? 1.0f : -1.0f;
        const int col0 = pn * BM + wc * 32 + 8 * fq;
#pragma unroll
        for (int ai = 0; ai < 2; ++ai)
#pragma unroll
            for (int m = 0; m < 4; ++m) {
                const int row = u.pm * BM + ai * HALF + wr * 64 + m * 16 + fr;
                bf16_t* rowp = PX + (size_t)row * PXW + col0;
                f32x4 c0 = (f32x4){1.f, 1.f, 1.f, 1.f}, c1 = c0, s0 = (f32x4){0.f, 0.f, 0.f, 0.f}, s1 = s0;
                if (rope) { const int pos = (wc & 1) ? (m * 16 + fr) : ((4 * u.pm + 2 * ai + wr) & 63); const int fo = pos * 16 + 8 * (fq & 1);
                    c0 = *(const f32x4*)(rcos + fo); c1 = *(const f32x4*)(rcos + fo + 4); s0 = *(const f32x4*)(rsin + fo) * sgn; s1 = *(const f32x4*)(rsin + fo + 4) * sgn; }
#pragma unroll
                for (int bj = 0; bj < 2; ++bj) {
                    f32x4 v0 = acc[ai][bj][m][0], v1 = acc[ai][bj][m][1];
                    if (gel) {
#pragma unroll
                        for (int i = 0; i < 4; ++i) { v0[i] = fgelu_tanh(v0[i]); v1[i] = fgelu_tanh(v1[i]); }
                    }
                    if (rope) { f32x4 p0, p1;
#pragma unroll
                        for (int i = 0; i < 4; ++i) { p0[i] = lane32_partner(v0[i], hi); p1[i] = lane32_partner(v1[i], hi); }
                        v0 = v0 * c0 + p0 * s0; v1 = v1 * c1 + p1 * s1; }
                    v0 = v0 * sc; v1 = v1 * sc;
                    u32x4 w; w.x = cvt_pk_bf16(v0[0], v0[1]); w.y = cvt_pk_bf16(v0[2], v0[3]); w.z = cvt_pk_bf16(v1[0], v1[1]); w.w = cvt_pk_bf16(v1[2], v1[3]);
                    *(u32x4*)(rowp + bj * HALF) = w;
                }
            }
    }
};

struct EpiGate {
    static constexpr bool PERM = true, AFTER_DRAIN = false;
    bf16_t* GS;
    __device__ __forceinline__ void operator()(const f32x4 (&acc)[2][2][4][2], const Unit& u, int wr, int wc, int fr, int fq) const {
        const int tid = tid_now();
#pragma unroll
        for (int ai = 0; ai < 2; ++ai)
#pragma unroll
            for (int bj = 0; bj < 2; ++bj)
#pragma unroll
                for (int m = 0; m < 4; ++m) {
                    const f32x4 a0 = acc[ai][bj][m][0], a1 = acc[ai][bj][m][1];
                    u32x4 w; w.x = cvt_pk_bf16(fsigmoid(a0[0]), fsigmoid(a0[1])); w.y = cvt_pk_bf16(fsigmoid(a0[2]), fsigmoid(a0[3]));
                    w.z = cvt_pk_bf16(fsigmoid(a1[0]), fsigmoid(a1[1])); w.w = cvt_pk_bf16(fsigmoid(a1[2]), fsigmoid(a1[3]));
                    *(u32x4*)(GS + ((size_t)(((ai * 2 + bj) * 4 + m) * 512 + tid)) * 8) = w;
                }
    }
};

struct EpiBranch {
    static constexpr bool PERM = true, AFTER_DRAIN = false;
    const bf16_t* GS; bf16_t* MG; int first;
    __device__ __forceinline__ void operator()(const f32x4 (&acc)[2][2][4][2], const Unit& u, int wr, int wc, int fr, int fq) const {
        const int tid = tid_now();
        const int row0 = u.pm * BM + wr * 64 + fr, col0 = u.pn * BM + wc * 32 + 8 * fq;
#pragma unroll
        for (int ai = 0; ai < 2; ++ai)
#pragma unroll
            for (int bj = 0; bj < 2; ++bj)
#pragma unroll
                for (int m = 0; m < 4; ++m) {
                    const u32x4 g = *(const u32x4*)(GS + ((size_t)(((ai * 2 + bj) * 4 + m) * 512 + tid)) * 8);
                    bf16_t* mp = MG + (size_t)(row0 + ai * HALF + m * 16) * 1024 + col0 + bj * HALF;
                    const f32x4 a0 = acc[ai][bj][m][0], a1 = acc[ai][bj][m][1];
                    float v[8] = {bf_lo(g.x) * a0[0], bf_hi(g.x) * a0[1], bf_lo(g.y) * a0[2], bf_hi(g.y) * a0[3], bf_lo(g.z) * a1[0], bf_hi(g.z) * a1[1], bf_lo(g.w) * a1[2], bf_hi(g.w) * a1[3]};
                    if (!first) { const u32x4 o = *(const u32x4*)mp;
                        v[0] += bf_lo(o.x); v[1] += bf_hi(o.x); v[2] += bf_lo(o.y); v[3] += bf_hi(o.y); v[4] += bf_lo(o.z); v[5] += bf_hi(o.z); v[6] += bf_lo(o.w); v[7] += bf_hi(o.w); }
                    u32x4 w; w.x = cvt_pk_bf16(v[0], v[1]); w.y = cvt_pk_bf16(v[2], v[3]); w.z = cvt_pk_bf16(v[4], v[5]); w.w = cvt_pk_bf16(v[6], v[7]);
                    *(u32x4*)mp = w;
                }
    }
};


struct EpiPart {
    static constexpr bool PERM = false, AFTER_DRAIN = false;
    float* P;
    __device__ __forceinline__ void operator()(const f32x4 (&acc)[2][2][4][2], const Unit& u, int wr, int wc, int fr, int fq) const {
        const int col0 = u.pn * BM + wc * 32 + 4 * fq;
#pragma unroll
        for (int ai = 0; ai < 2; ++ai)
#pragma unroll
            for (int m = 0; m < 4; ++m) {
                float* rp = P + (size_t)((u.pm - 64) * BM + ai * HALF + wr * 64 + m * 16 + fr) * 1024 + col0;
#pragma unroll
                for (int bj = 0; bj < 2; ++bj)
#pragma unroll
                    for (int n = 0; n < 2; ++n) *(f32x4*)(rp + bj * HALF + n * 16) = acc[ai][bj][m][n];
            }
    }
};
template <class Epi, class Sched, bool ALIGN_EPI = false, bool SP2 = false>
__device__ __forceinline__ void gemm_phase(PG8_LAS unsigned char* lds, const Gemm g, const Sched& S, const Epi& E) {
    const int tid = tid_now(), wid = __builtin_amdgcn_readfirstlane(tid >> 6), lane = tid & 63, wr = wid >> 2, wc = wid & 3, fr = lane & 15, fq = lane >> 4;
    const int K = g.K, nt = K / BK;
    unsigned voffA[2], voffB[2];
#pragma unroll
    for (int i = 0; i < 2; ++i) { int R, C; stage_rc(tid * 16 + i * 8192, R, C); const int Rb = Epi::PERM ? ((R & ~31) + perm32(R & 31)) : R;
        voffA[i] = (unsigned)(R * g.lda + C) * 2u; voffB[i] = (unsigned)(Rb * g.ldb + C) * 2u; }
    const size_t kstep = (size_t)(BK * 2);
    const size_t hsA = (size_t)HALF * g.lda * 2, hsB = (size_t)HALF * g.ldb * 2;
    const size_t tsA = 2 * hsA, tsB = 2 * hsB;
    const unsigned ldsw = (unsigned)wid * 1024u;
    const int aoff = lds_byte(wr * 64 + fr, fq * 8), boff = lds_byte(wc * 32 + fr, fq * 8);
#define PG8_SA(b, h) (((b) * 2 + (h)) * HTB)
#define PG8_SB(b, h) ((4 + (b) * 2 + (h)) * HTB)
#define PG8_STAGE(bufoff, gbase, voff) do { _Pragma("unroll") for (int _i = 0; _i < 2; ++_i) \
        __builtin_amdgcn_global_load_lds((const unsigned*)((const char*)(gbase) + (voff)[_i]), (PG8_LAS unsigned*)(lds + (bufoff) + ldsw + _i * 8192), 16, 0, 0); } while (0)
#define PG8_LDA(dst, b, h) do { _Pragma("unroll") for (int m = 0; m < 4; ++m) _Pragma("unroll") for (int k = 0; k < 2; ++k) dst[m][k] = *(const PG8_LAS bf16x8*)(lds + PG8_SA(b, h) + aoff + m * 2048 + k * 1024); } while (0)
#define PG8_LDB(dst, b, h) do { _Pragma("unroll") for (int n = 0; n < 2; ++n) _Pragma("unroll") for (int k = 0; k < 2; ++k) dst[n][k] = *(const PG8_LAS bf16x8*)(lds + PG8_SB(b, h) + boff + n * 2048 + k * 1024); } while (0)
#define PG8_MMA(ai, bj, At, Bt) do { __builtin_amdgcn_s_setprio(1); _Pragma("unroll") for (int m = 0; m < 4; ++m) _Pragma("unroll") for (int n = 0; n < 2; ++n) _Pragma("unroll") for (int k = 0; k < 2; ++k) \
        acc[ai][bj][m][n] = __builtin_amdgcn_mfma_f32_16x16x32_bf16(Bt[n][k], At[m][k], acc[ai][bj][m][n], 0, 0, 0); __builtin_amdgcn_s_setprio(0); } while (0)
#define PG8_WAIT_V(n) asm volatile("s_waitcnt vmcnt(" #n ")" ::: "memory")
#define PG8_WAIT_L(n) asm volatile("s_waitcnt lgkmcnt(" #n ")" ::: "memory")
#define PG8_BAR __builtin_amdgcn_s_barrier()
#define PG8_SCHED __builtin_amdgcn_sched_barrier(0)
    Unit cur, nxt; int ui = 0;
    if (!S.next(0, cur)) return;
    f32x4 acc[2][2][4][2];
#pragma unroll
    for (int a = 0; a < 2; ++a)
#pragma unroll
        for (int b = 0; b < 2; ++b)
#pragma unroll
            for (int m = 0; m < 4; ++m)
#pragma unroll
                for (int n = 0; n < 2; ++n) acc[a][b][m][n] = (f32x4){0.f, 0.f, 0.f, 0.f};
    bf16x8 At[4][2], B0[2][2], B1[2][2];
    const char* cA = (const char*)g.A + (size_t)cur.pm * tsA; const char* cB = (const char*)g.Bt + (size_t)cur.pn * tsB;
    S.a_ready(cur);
    if constexpr (SP2) {
        PG8_STAGE(PG8_SB(0, 0), cB, voffB); PG8_STAGE(PG8_SB(0, 1), cB + hsB, voffB); PG8_STAGE(PG8_SA(0, 0), cA, voffA); PG8_STAGE(PG8_SA(0, 1), cA + hsA, voffA);
        if (wr == 1) PG8_BAR;
        PG8_WAIT_V(2); PG8_BAR;
        PG8_STAGE(PG8_SB(1, 0), cB + kstep, voffB); PG8_STAGE(PG8_SA(1, 0), cA + kstep, voffA); PG8_STAGE(PG8_SB(1, 1), cB + hsB + kstep, voffB);
        PG8_WAIT_V(6); PG8_BAR;
    } else {
        PG8_STAGE(PG8_SB(0, 0), cB, voffB); PG8_STAGE(PG8_SA(0, 0), cA, voffA); PG8_STAGE(PG8_SB(0, 1), cB + hsB, voffB); PG8_STAGE(PG8_SA(0, 1), cA + hsA, voffA);
        if (wr == 1) PG8_BAR;
        PG8_WAIT_V(4); PG8_BAR;
        PG8_STAGE(PG8_SB(1, 0), cB + kstep, voffB); PG8_STAGE(PG8_SA(1, 0), cA + kstep, voffA); PG8_STAGE(PG8_SB(1, 1), cB + hsB + kstep, voffB);
        PG8_WAIT_V(6); PG8_BAR;
    }
    for (;;) {
        const bool has_next = S.next(ui + 1, nxt);
        const char* nA = has_next ? (const char*)g.A + (size_t)nxt.pm * tsA : cA; const char* nB = has_next ? (const char*)g.Bt + (size_t)nxt.pn * tsB : cB;
        for (int t = 0; t < nt; t += 2) {
            const bool last = (t == nt - 2);
            const char* a1 = cA + (size_t)(t + 1) * kstep;
            const char* a2 = last ? nA : cA + (size_t)(t + 2) * kstep; const char* b2 = last ? nB : cB + (size_t)(t + 2) * kstep;
            const char* a3 = a2 + kstep; const char* b3 = b2 + kstep;
            if (last && has_next) S.a_ready(nxt);
            if constexpr (SP2) {
            PG8_LDB(B0, 0, 0); PG8_LDB(B1, 0, 1); PG8_SCHED; PG8_LDA(At, 0, 0); PG8_STAGE(PG8_SA(1, 1), a1 + hsA, voffA);
            PG8_WAIT_V(8); PG8_WAIT_L(0); PG8_BAR; PG8_MMA(0, 0, At, B0); PG8_MMA(0, 1, At, B1); PG8_BAR; PG8_SCHED;
            PG8_LDA(At, 0, 1); PG8_STAGE(PG8_SB(0, 0), b2, voffB); PG8_STAGE(PG8_SB(0, 1), b2 + hsB, voffB); PG8_STAGE(PG8_SA(0, 0), a2, voffA);
            PG8_WAIT_V(8); PG8_WAIT_L(0); PG8_BAR; PG8_MMA(1, 0, At, B0); PG8_MMA(1, 1, At, B1); PG8_BAR; PG8_SCHED;
            PG8_LDB(B0, 1, 0); PG8_LDB(B1, 1, 1); PG8_SCHED; PG8_LDA(At, 1, 0); PG8_STAGE(PG8_SA(0, 1), a2 + hsA, voffA);
            PG8_WAIT_V(8); PG8_WAIT_L(0); PG8_BAR; PG8_MMA(0, 0, At, B0); PG8_MMA(0, 1, At, B1); PG8_BAR; PG8_SCHED;
            PG8_LDA(At, 1, 1); PG8_STAGE(PG8_SB(1, 0), b3, voffB); PG8_STAGE(PG8_SB(1, 1), b3 + hsB, voffB); PG8_STAGE(PG8_SA(1, 0), a3, voffA);
            PG8_WAIT_V(8); PG8_WAIT_L(0); PG8_BAR; PG8_MMA(1, 0, At, B0); PG8_MMA(1, 1, At, B1); PG8_BAR; PG8_SCHED;
            } else {
            PG8_LDB(B0, 0, 0); PG8_SCHED; PG8_LDA(At, 0, 0); PG8_STAGE(PG8_SA(1, 1), a1 + hsA, voffA);
            PG8_WAIT_L(8); PG8_BAR; PG8_WAIT_L(0); PG8_MMA(0, 0, At, B0); PG8_BAR; PG8_SCHED;
            PG8_LDB(B1, 0, 1); PG8_STAGE(PG8_SB(0, 0), b2, voffB);
            PG8_BAR; PG8_WAIT_L(0); PG8_MMA(0, 1, At, B1); PG8_BAR;
            PG8_LDA(At, 0, 1); PG8_STAGE(PG8_SA(0, 0), a2, voffA);
            PG8_BAR; PG8_WAIT_L(0); PG8_MMA(1, 0, At, B0); PG8_BAR; PG8_SCHED;
            PG8_STAGE(PG8_SB(0, 1), b2 + hsB, voffB);
            PG8_WAIT_V(6); PG8_BAR; PG8_MMA(1, 1, At, B1); PG8_BAR;
            PG8_LDB(B0, 1, 0); PG8_SCHED; PG8_LDA(At, 1, 0); PG8_STAGE(PG8_SA(0, 1), a2 + hsA, voffA);
            PG8_WAIT_L(8); PG8_BAR; PG8_WAIT_L(0); PG8_MMA(0, 0, At, B0); PG8_BAR; PG8_SCHED;
            PG8_LDB(B1, 1, 1); PG8_STAGE(PG8_SB(1, 0), b3, voffB);
            PG8_BAR; PG8_WAIT_L(0); PG8_MMA(0, 1, At, B1); PG8_BAR;
            PG8_LDA(At, 1, 1); PG8_STAGE(PG8_SA(1, 0), a3, voffA);
            PG8_BAR; PG8_WAIT_L(0); PG8_MMA(1, 0, At, B0); PG8_BAR; PG8_SCHED;
            PG8_STAGE(PG8_SB(1, 1), b3 + hsB, voffB);
            PG8_WAIT_V(6); PG8_BAR; PG8_MMA(1, 1, At, B1); PG8_BAR;
            }
        }
        if constexpr (ALIGN_EPI) { if (wr == 0) PG8_BAR; }
        if constexpr (!Epi::AFTER_DRAIN) { E(acc, cur, wr, wc, fr, fq); S.done(cur); }
        if (!has_next) break;
#pragma unroll
        for (int a = 0; a < 2; ++a)
#pragma unroll
            for (int b = 0; b < 2; ++b)
#pragma unroll
                for (int m = 0; m < 4; ++m)
#pragma unroll
                    for (int n = 0; n < 2; ++n) acc[a][b][m][n] = (f32x4){0.f, 0.f, 0.f, 0.f};
        cur = nxt; cA = nA; cB = nB; ++ui;
        if constexpr (ALIGN_EPI) { if (wr == 1) PG8_BAR; }
    }
    PG8_WAIT_V(0);
    if constexpr (!ALIGN_EPI) { if (wr == 0) PG8_BAR; }
    PG8_BAR;
    if constexpr (Epi::AFTER_DRAIN) { E.fused(acc, cur, wr, wc, fr, fq, lds, wid, lane); S.done(cur); }
#undef PG8_SA
#undef PG8_SB
#undef PG8_STAGE
#undef PG8_LDA
#undef PG8_LDB
#undef PG8_MMA
#undef PG8_WAIT_V
#undef PG8_WAIT_L
#undef PG8_BAR
#undef PG8_SCHED
}
}
namespace attn_body {
using bf16=__hip_bfloat16;
using bf16x8=__attribute__((ext_vector_type(8)))short;
using s16x4=__attribute__((ext_vector_type(4)))short;
using f32x16=__attribute__((ext_vector_type(16)))float;
using u32x4=__attribute__((ext_vector_type(4)))unsigned;
constexpr int D=64,QP=3328,OP=1024;
constexpr int NW=8,QBLK=32,QB=QBLK*NW,KVBLK=64;
constexpr int ATTN_UNIT_ROWS=QB;
__device__ __forceinline__ int crow(int r,int hi){return (r&3)+8*(r>>2)+4*hi;}
#define SBAR() __builtin_amdgcn_sched_barrier(0)
__device__ __forceinline__ void cmask(f32x16&p0,f32x16&p1,int jb,int qrel,int hi){
  const float NEG=-INFINITY; int kb=64*jb+4*hi;
  #pragma unroll
  for(int r=0;r<16;++r){int kv=kb+(r&3)+8*(r>>2); if(kv>qrel)p0[r]=NEG; if(kv+32>qrel)p1[r]=NEG;}
}

constexpr int NSLOT=3, SLOTB=8192;
constexpr int LDS_K=0, LDS_V=NSLOT*SLOTB, LDS_WS=2*NSLOT*SLOTB, LDS_OST=LDS_WS+NW*64*4, LDS_BYTES=LDS_OST+NW*4096;
constexpr float C2=0.125f*1.4426950408889634f;
__device__ __forceinline__ void glds16(const void*gsrc,unsigned lds_dst){unsigned keep;
  asm volatile("s_mov_b32 %0, m0\n\ts_mov_b32 m0, %2\n\ts_nop 0\n\tglobal_load_lds_dwordx4 %1, off\n\ts_mov_b32 m0, %0":"=&s"(keep):"v"(gsrc),"s"(lds_dst):"memory");}
__device__ __forceinline__ float max3f(float a,float b,float c){float r;asm("v_max3_f32 %0, %1, %2, %3":"=v"(r):"v"(a),"v"(b),"v"(c));return r;}
__device__ __forceinline__ float max2f(float a,float b){float r;asm("v_max_f32_e32 %0, %1, %2":"=v"(r):"v"(a),"v"(b));return r;}
__device__ __forceinline__ float fadd_s(float a,float b){float r;asm("v_add_f32_e32 %0, %1, %2":"=v"(r):"v"(a),"v"(b));return r;}
__device__ __forceinline__ float fsub_s(float a,float b){float r;asm("v_sub_f32_e32 %0, %1, %2":"=v"(r):"v"(a),"v"(b));return r;}
typedef float f32x2_t __attribute__((ext_vector_type(2))); typedef __bf16 bf16x2_t __attribute__((ext_vector_type(2)));
__device__ __forceinline__ unsigned cvtpk_s(float lo,float hi){f32x2_t v={lo,hi};bf16x2_t b=__builtin_convertvector(v,bf16x2_t);return __builtin_bit_cast(unsigned,b);}
#define WAIT_BAR(N) asm volatile("s_waitcnt vmcnt(" #N ") lgkmcnt(0)\n\ts_barrier":::"memory")

__device__ __forceinline__ void qkt(f32x16&p0,f32x16&p1,const char*Kslot,const bf16x8*qr,const f32x16&negm,int r32,int hi){
  const char*kb=Kslot+hi*1024+r32*16;
  #pragma unroll
  for(int d0=0;d0<4;++d0){
    const bf16x8 b0=*reinterpret_cast<const bf16x8*>(kb+d0*2048);
    const bf16x8 b1=*reinterpret_cast<const bf16x8*>(kb+d0*2048+512);
    if(d0==0){p0=__builtin_amdgcn_mfma_f32_32x32x16_bf16(b0,qr[0],negm,0,0,0);p1=__builtin_amdgcn_mfma_f32_32x32x16_bf16(b1,qr[0],negm,0,0,0);}
    else{p0=__builtin_amdgcn_mfma_f32_32x32x16_bf16(b0,qr[d0],p0,0,0,0);p1=__builtin_amdgcn_mfma_f32_32x32x16_bf16(b1,qr[d0],p1,0,0,0);}}
}
typedef __attribute__((address_space(3))) const char* lds_cptr;
typedef short v4i16_t __attribute__((ext_vector_type(4)));
__device__ __forceinline__ void kload8(bf16x8*kf,lds_cptr kp){
  kf[0]=*(const __attribute__((address_space(3))) bf16x8*)(kp);      kf[1]=*(const __attribute__((address_space(3))) bf16x8*)(kp+512);
  kf[2]=*(const __attribute__((address_space(3))) bf16x8*)(kp+2048); kf[3]=*(const __attribute__((address_space(3))) bf16x8*)(kp+2560);
  kf[4]=*(const __attribute__((address_space(3))) bf16x8*)(kp+4096); kf[5]=*(const __attribute__((address_space(3))) bf16x8*)(kp+4608);
  kf[6]=*(const __attribute__((address_space(3))) bf16x8*)(kp+6144); kf[7]=*(const __attribute__((address_space(3))) bf16x8*)(kp+6656);
}
__device__ __forceinline__ void kload2(bf16x8*kf,lds_cptr kp,int j){ kf[2*j]=*(const __attribute__((address_space(3))) bf16x8*)(kp+j*2048); kf[2*j+1]=*(const __attribute__((address_space(3))) bf16x8*)(kp+j*2048+512); }
__device__ __forceinline__ s16x4 vtr(lds_cptr p){ return __builtin_bit_cast(s16x4,__builtin_amdgcn_ds_read_tr16_b64_v4i16((__attribute__((address_space(3))) v4i16_t*)p)); }
__device__ __forceinline__ float rowmax(const f32x16&p0,const f32x16&p1){
  float a=max3f(p0[0],p0[1],p1[0]),b=max3f(p0[2],p0[3],p1[1]);a=max3f(a,p1[2],p1[3]);
  #pragma unroll
  for(int r=4;r<16;r+=4){a=max3f(a,p0[r],p0[r+1]);b=max3f(b,p0[r+2],p0[r+3]);a=max3f(a,p1[r],p1[r+1]);b=max3f(b,p1[r+2],p1[r+3]);}
  const float m=max2f(a,b);
  auto rr=__builtin_amdgcn_permlane32_swap(__float_as_uint(m),__float_as_uint(m),false,false);
  return max2f(__uint_as_float(rr[0]),__uint_as_float(rr[1]));
}
__device__ __forceinline__ void pv(f32x16*o,int vb,bf16x8 pa0,bf16x8 pa1,bf16x8 pa2,bf16x8 pa3){
  #pragma unroll
  for(int d0=0;d0<2;++d0){s16x4 lo[4],hi[4];
    #pragma unroll
    for(int ks=0;ks<4;++ks){
      asm volatile("ds_read_b64_tr_b16 %0,%1 offset:%c2":"=&v"(lo[ks]):"v"(vb),"i"(d0*4096+ks*1024):"memory");
      asm volatile("ds_read_b64_tr_b16 %0,%1 offset:%c2":"=&v"(hi[ks]):"v"(vb),"i"(d0*4096+ks*1024+512):"memory");}
    asm volatile("s_waitcnt lgkmcnt(0)":::"memory");SBAR();
    #define PK(k) (bf16x8){lo[k][0],lo[k][1],lo[k][2],lo[k][3],hi[k][0],hi[k][1],hi[k][2],hi[k][3]}
    o[d0]=__builtin_amdgcn_mfma_f32_32x32x16_bf16(pa0,PK(0),o[d0],0,0,0);
    o[d0]=__builtin_amdgcn_mfma_f32_32x32x16_bf16(pa1,PK(1),o[d0],0,0,0);
    o[d0]=__builtin_amdgcn_mfma_f32_32x32x16_bf16(pa2,PK(2),o[d0],0,0,0);
    o[d0]=__builtin_amdgcn_mfma_f32_32x32x16_bf16(pa3,PK(3),o[d0],0,0,0);
    #undef PK
  }
}

#ifndef ATTN_STORE16
#define ATTN_STORE16(p,v) (*(u32x4*)(p)=(v))
#endif
template<int THRL> __device__ __forceinline__ void attn_unit(const bf16*Qu,const bf16*__restrict__ Kc,const bf16*__restrict__ Vc,bf16*Ou,int krow0,int nt_main,int krow1,int NT,char*shm){
  const int tid=tid_now(),lane=tid&63,r32=lane&31,hi=lane>>5; const int wid=__builtin_amdgcn_readfirstlane(tid>>6);
  const bf16*Qw=Qu+(long)(wid*QBLK)*QP;
  const unsigned lds0=(unsigned)(uintptr_t)shm;
  float*wsf=(float*)(shm+LDS_WS)+wid*64;
  const bf16*ksrc=Kc+(long)lane*QP+wid*8;
  const bf16*vsrc=Vc+(long)(16*(wid&3)+(lane>>2))*QP+(wid>>2)*32+(lane&3)*8;
  const unsigned kdst=lds0+LDS_K+wid*1024, vdst=lds0+LDS_V+wid*1024;
  #define KROW(t) (((t)<nt_main)?(krow0+(t)*KVBLK):(krow1+((t)-nt_main)*KVBLK))
  #define DMA_K(t,slot) glds16(ksrc+(long)KROW(t)*QP,(unsigned)__builtin_amdgcn_readfirstlane(kdst+(slot)))
  #define DMA_V(t,slot) glds16(vsrc+(long)KROW(t)*QP,(unsigned)__builtin_amdgcn_readfirstlane(vdst+(slot)))
  const int vb0=(int)(lds0+LDS_V)+((lane>>4)&1)*32+(lane&3)*8+(4*hi+((lane&15)>>2))*64;
  const char*Kbase=shm+LDS_K; bf16x8 kf[8];
  const lds_cptr shm3=(lds_cptr)shm; const lds_cptr kp0=shm3+LDS_K+hi*1024+r32*16; const lds_cptr vp0=shm3+LDS_V+((lane>>4)&1)*32+(lane&3)*8+(4*hi+((lane&15)>>2))*64;
  DMA_K(0,0);DMA_V(0,0);DMA_K(1,SLOTB);
  bf16x8 qr[4];
  #pragma unroll
  for(int d0=0;d0<4;++d0)qr[d0]=*reinterpret_cast<const bf16x8*>(&Qw[(long)r32*QP+d0*16+hi*8]);
  float mhat=0.f,l_reg=0.f;f32x16 o[2];o[0]=f32x16{};o[1]=f32x16{};f32x16 negm=f32x16{};asm volatile("":"+v"(negm));
  const int qrel=wid*QBLK+r32;
  #define CMASK(P0,P1,t) do{}while(0)
  bool resc=false;
  #define START(P0,P1) do{ const float rm=rowmax(P0,P1); resc=false; \
    { const float dl=rm; mhat=fadd_s(mhat,dl); \
      _Pragma("unroll") for(int r=0;r<16;++r){P0[r]=fsub_s(P0[r],dl);P1[r]=fsub_s(P1[r],dl);} \
      _Pragma("unroll") for(int r=0;r<16;++r)negm[r]=-mhat; asm volatile("":"+v"(negm)); } \
    _Pragma("unroll") for(int r=0;r<16;++r)P0[r]=__builtin_amdgcn_exp2f(P0[r]); }while(0)
  #define RESC() do{ if(resc){ asm volatile("s_waitcnt lgkmcnt(0)":::"memory"); \
      _Pragma("unroll") for(int d_=0;d_<2;++d_) _Pragma("unroll") for(int r=0;r<16;++r)o[d_][r]*=wsf[crow(r,hi)]; } }while(0)
  f32x16 pA0,pA1,pB0,pB1;
  int sl_prev=0,sl_cur=0,sl_next=SLOTB;
  #define ROT() do{sl_prev=sl_cur;sl_cur=sl_next;sl_next=(sl_next==(NSLOT-1)*SLOTB)?0:sl_next+SLOTB;}while(0)
  DMA_K(2,2*SLOTB);
  WAIT_BAR(3);
  qkt(pA0,pA1,Kbase,qr,negm,r32,hi);asm volatile("s_nop 15\n\ts_nop 7":"+v"(pA0),"+v"(pA1));CMASK(pA0,pA1,0);
  START(pA0,pA1);
  _Pragma("unroll") for(int r=0;r<16;++r)pA1[r]=__builtin_amdgcn_exp2f(pA1[r]);
  WAIT_BAR(0);
  DMA_K(3,0);DMA_V(1,SLOTB);
  ROT();
  kload8(kf,kp0+sl_cur);
  WAIT_BAR(2);
  s16x4 vlo[8],vhi[8]; u32x4 pw0,pw1,pw2,pw3;
  #define PKW(P,B) cvtpk_s(P[B],P[B+1])
  #define PAF(k) __builtin_bit_cast(bf16x8,pw##k)
  #define VFR(i) (bf16x8){vlo[i][0],vlo[i][1],vlo[i][2],vlo[i][3],vhi[i][0],vhi[i][1],vhi[i][2],vhi[i][3]}
  #define PIN(x) asm volatile("":"+v"(x))
  #define MX3(a,b,c) __builtin_fmaxf(__builtin_fmaxf((a),(b)),(c))
  #define GAPA(MF,A0,A1,A2,A3,W0,W1,PW) do{ MF; sacc+=A0; sacc+=A1; sacc+=A2; sacc+=A3; PIN(sacc); W0; W1; PIN(PW); SBAR(); }while(0)
  #define EX(v) __builtin_amdgcn_exp2f(v)
  #define GAPB(MF,X,B) do{ MF; X[B]=EX(X[B]); X[B+1]=EX(X[B+1]); X[B+2]=EX(X[B+2]); X[B+3]=EX(X[B+3]); PIN(X); SBAR(); }while(0)
  #define VRD(i) do{ vlo[i]=vtr(vp_+(((i)>>2)*4096+((i)&3)*1024)); vhi[i]=vtr(vp_+(((i)>>2)*4096+((i)&3)*1024+512)); }while(0)
  #define KRD(G,j) do{ if(G){ kload2(kf,kp0+sl_next,j); SBAR(); } }while(0)
  #define STEP(C0,C1,P0,P1,t,GK,GV,GL) do{ SBAR(); \
    const lds_cptr vp_=vp0+sl_prev; \
    VRD(0); SBAR(); float sacc=(P0[0]+P0[1]); \
    GAPA(C0=__builtin_amdgcn_mfma_f32_32x32x16_bf16(kf[0],qr[0],negm,0,0,0), P0[2],P0[3],P0[4],P0[5],     pw0[0]=PKW(P0,0), pw0[1]=PKW(P0,2), pw0); \
    VRD(4); SBAR(); GAPA(C1=__builtin_amdgcn_mfma_f32_32x32x16_bf16(kf[1],qr[0],negm,0,0,0), P0[6],P0[7],P0[8],P0[9],     pw0[2]=PKW(P0,4), pw0[3]=PKW(P0,6), pw0); \
    VRD(1); SBAR(); GAPA(C0=__builtin_amdgcn_mfma_f32_32x32x16_bf16(kf[2],qr[1],C0,0,0,0),   P0[10],P0[11],P0[12],P0[13], pw1[0]=PKW(P0,8), pw1[1]=PKW(P0,10), pw1); \
    VRD(5); SBAR(); GAPA(C1=__builtin_amdgcn_mfma_f32_32x32x16_bf16(kf[3],qr[1],C1,0,0,0),   P0[14],P0[15],P1[0],P1[1],   pw1[2]=PKW(P0,12),pw1[3]=PKW(P0,14), pw1); \
    VRD(2); SBAR(); GAPA(C0=__builtin_amdgcn_mfma_f32_32x32x16_bf16(kf[4],qr[2],C0,0,0,0),   P1[2],P1[3],P1[4],P1[5],     pw2[0]=PKW(P1,0), pw2[1]=PKW(P1,2), pw2); \
    VRD(6); SBAR(); GAPA(C1=__builtin_amdgcn_mfma_f32_32x32x16_bf16(kf[5],qr[2],C1,0,0,0),   P1[6],P1[7],P1[8],P1[9],     pw2[2]=PKW(P1,4), pw2[3]=PKW(P1,6), pw2); \
    VRD(3); SBAR(); GAPA(C0=__builtin_amdgcn_mfma_f32_32x32x16_bf16(kf[6],qr[3],C0,0,0,0),   P1[10],P1[11],P1[12],P1[13], pw3[0]=PKW(P1,8), pw3[1]=PKW(P1,10), pw3); \
    VRD(7); SBAR(); GAPA(C1=__builtin_amdgcn_mfma_f32_32x32x16_bf16(kf[7],qr[3],C1,0,0,0),   P1[14],P1[15],0.f,0.f,       pw3[2]=PKW(P1,12),pw3[3]=PKW(P1,14), pw3); \
    l_reg+=sacc; \
    if(GK){DMA_K((t)+3,sl_cur);} if(GV){DMA_V((t)+1,sl_next);} \
    CMASK(C0,C1,t); \
    { float a=MX3(C0[0],C0[1],C1[0]),b=MX3(C0[2],C0[3],C1[1]); a=MX3(a,C1[2],C1[3]); \
      _Pragma("unroll") for(int r=4;r<16;r+=4){a=MX3(a,C0[r],C0[r+1]);b=MX3(b,C0[r+2],C0[r+3]);a=MX3(a,C1[r],C1[r+1]);b=MX3(b,C1[r+2],C1[r+3]);} \
      float rm=__builtin_fmaxf(a,b); { auto rr=__builtin_amdgcn_permlane32_swap(__float_as_uint(rm),__float_as_uint(rm),false,false); rm=__builtin_fmaxf(__uint_as_float(rr[0]),__uint_as_float(rr[1])); } \
      resc=false; \
      if(__builtin_expect(__any(rm>(float)THRL),0)){ const float dl=__builtin_fmaxf(rm,0.f); mhat+=dl; \
        _Pragma("unroll") for(int r=0;r<16;++r){C0[r]-=dl;C1[r]-=dl;} \
        _Pragma("unroll") for(int r=0;r<16;++r)negm[r]=-mhat; asm volatile("":"+v"(negm)); \
        const float f=__builtin_amdgcn_exp2f(-dl); l_reg*=f; if(hi==0)wsf[r32]=f; resc=true; } } \
    SBAR(); \
    GAPB(o[0]=__builtin_amdgcn_mfma_f32_32x32x16_bf16(PAF(0),VFR(0),o[0],0,0,0), C0,0); \
    GAPB(o[1]=__builtin_amdgcn_mfma_f32_32x32x16_bf16(PAF(0),VFR(4),o[1],0,0,0), C0,4); \
    KRD(GL,0); GAPB(o[0]=__builtin_amdgcn_mfma_f32_32x32x16_bf16(PAF(1),VFR(1),o[0],0,0,0), C0,8); \
    KRD(GL,1); GAPB(o[1]=__builtin_amdgcn_mfma_f32_32x32x16_bf16(PAF(1),VFR(5),o[1],0,0,0), C0,12); \
    KRD(GL,2); GAPB(o[0]=__builtin_amdgcn_mfma_f32_32x32x16_bf16(PAF(2),VFR(2),o[0],0,0,0), C1,0); \
    KRD(GL,3); GAPB(o[1]=__builtin_amdgcn_mfma_f32_32x32x16_bf16(PAF(2),VFR(6),o[1],0,0,0), C1,4); \
    GAPB(o[0]=__builtin_amdgcn_mfma_f32_32x32x16_bf16(PAF(3),VFR(3),o[0],0,0,0), C1,8); \
    GAPB(o[1]=__builtin_amdgcn_mfma_f32_32x32x16_bf16(PAF(3),VFR(7),o[1],0,0,0), C1,12); \
    }while(0)
  int t=1;
  #undef CMASK
  #define CMASK(P0,P1,t) do{}while(0)
  for(;t+5<NT;t+=2){
    STEP(pB0,pB1,pA0,pA1,t,true,true,true);     WAIT_BAR(2); RESC(); ROT();
    STEP(pA0,pA1,pB0,pB1,t+1,true,true,true);   WAIT_BAR(2); RESC(); ROT();
  }
  #undef CMASK
  #define CMASK(P0,P1,t) do{}while(0)
  #define ENDW(tt) do{ if((tt)+3<NT){WAIT_BAR(2);} else if((tt)+2<NT){WAIT_BAR(1);} else {WAIT_BAR(0);} }while(0)
  for(;t+1<NT;t+=2){
    STEP(pB0,pB1,pA0,pA1,t,(t+3<NT),(t+1<NT),(t+1<NT));       ENDW(t);   RESC(); ROT();
    STEP(pA0,pA1,pB0,pB1,t+1,(t+4<NT),(t+2<NT),(t+2<NT));     ENDW(t+1); RESC(); ROT();
  }
  STEP(pB0,pB1,pA0,pA1,NT-1,false,false,false); RESC();
  { float sacc=pB0[0]+pB0[1]; _Pragma("unroll") for(int r=2;r<16;++r)sacc+=pB0[r]; _Pragma("unroll") for(int r=0;r<16;++r)sacc+=pB1[r]; l_reg+=sacc;
    pw0=(u32x4){PKW(pB0,0),PKW(pB0,2),PKW(pB0,4),PKW(pB0,6)};pw1=(u32x4){PKW(pB0,8),PKW(pB0,10),PKW(pB0,12),PKW(pB0,14)};pw2=(u32x4){PKW(pB1,0),PKW(pB1,2),PKW(pB1,4),PKW(pB1,6)};pw3=(u32x4){PKW(pB1,8),PKW(pB1,10),PKW(pB1,12),PKW(pB1,14)};
    SBAR(); pv(o,vb0+sl_cur,PAF(0),PAF(1),PAF(2),PAF(3)); }
  #undef PKW
  #undef PAF
  #undef VFR
  #undef PIN
  #undef MX3
  #undef GAPA
  #undef GAPB
  #undef EX
  #undef VRD
  #undef KRD
  #undef STEP
  #undef ENDW
  {auto rr=__builtin_amdgcn_permlane32_swap(__float_as_uint(l_reg),__float_as_uint(l_reg),false,false);l_reg=__uint_as_float(rr[0])+__uint_as_float(rr[1]);}
  if(hi==0)wsf[32+r32]=l_reg;asm volatile("s_waitcnt lgkmcnt(0)":::"memory");
  float rli[16];
  #pragma unroll
  for(int r=0;r<16;++r)rli[r]=__builtin_amdgcn_rcpf(wsf[32+crow(r,hi)]);
  bf16*Ow=Ou+(long)(wid*QBLK)*OP;
  { bf16*stg=(bf16*)(shm+LDS_OST)+wid*2048;
    #pragma unroll
    for(int r=0;r<16;++r){const int orow=crow(r,hi);
      #pragma unroll
      for(int d0=0;d0<2;++d0)stg[orow*64+d0*32+r32]=__float2bfloat16(o[d0][r]*rli[r]);}
    asm volatile("s_waitcnt lgkmcnt(0)":::"memory");
    #pragma unroll
    for(int i=0;i<4;++i){const int row=i*8+(lane>>3),ch=lane&7; const u32x4 v=*(const u32x4*)(stg+row*64+ch*8); ATTN_STORE16(Ow+(long)row*OP+ch*8,v);} }
  asm volatile("s_waitcnt lgkmcnt(0)\n\ts_barrier":::"memory");
  #undef DMA_K
  #undef KROW
  #undef DMA_V
  #undef CMASK
  #undef START
  #undef RESC
  #undef ROT
}

__device__ __forceinline__ void pv16(f32x16*o,int vb,bf16x8 pa0,bf16x8 pa1,bf16x8 pa2,bf16x8 pa3){
  pv(o,vb,pa0,pa1,pa2,pa3); pv(o+2,vb+8192,pa0,pa1,pa2,pa3);
}
template<int THRL> __device__ __forceinline__ void attn_unit2(const bf16*Qu,const bf16*__restrict__ Kc,const bf16*__restrict__ Vc,bf16*Ou,int krow0,int nt_main,int krow1,int NT,char*shm){
  const int tid=tid_now(),lane=tid&63,r32=lane&31,hi=lane>>5; const int wid=__builtin_amdgcn_readfirstlane(tid>>6);
  const bool grpB=wid>=4;
  constexpr int KS=8192,VS=16384,L_K=0,L_V=4*KS,L_WS=L_V+4*VS,L_OST=0;
  const bf16*Qw=Qu+(long)(wid*QBLK)*QP;
  const unsigned lds0=(unsigned)(uintptr_t)shm;
  float*wsf=(float*)(shm+L_WS)+wid*64;
  const bf16*ksrc=Kc+(long)lane*QP+wid*8;
  const bf16*vsrc=Vc+(long)(16*(wid&3)+(lane>>2))*QP+(wid>>2)*32+(lane&3)*8;
  const unsigned kdst=lds0+L_K+wid*1024, vdst=lds0+L_V+wid*1024;
  #define KROW2(t) (((t)<nt_main)?(krow0+(t)*KVBLK):(krow1+((t)-nt_main)*KVBLK))
  #define DMA2(t,s) do{ const long ro_=(long)KROW2(t)*QP; glds16(ksrc+ro_,(unsigned)__builtin_amdgcn_readfirstlane(kdst+(s)*KS)); \
      glds16(vsrc+ro_,(unsigned)__builtin_amdgcn_readfirstlane(vdst+(s)*VS)); glds16(vsrc+ro_+64,(unsigned)__builtin_amdgcn_readfirstlane(vdst+(s)*VS+8192)); }while(0)
  const int vb0=(int)(lds0+L_V)+((lane>>4)&1)*32+(lane&3)*8+(4*hi+((lane&15)>>2))*64;
  DMA2(0,0); if(NT>1) DMA2(1,1);
  bf16x8 qr[4];
  #pragma unroll
  for(int d0=0;d0<4;++d0)qr[d0]=*reinterpret_cast<const bf16x8*>(&Qw[(long)r32*QP+d0*16+hi*8]);
  float mhat=0.f,l_reg=0.f; f32x16 o[4]; o[0]=f32x16{};o[1]=f32x16{};o[2]=f32x16{};o[3]=f32x16{}; f32x16 negm=f32x16{};
  u32x4 pw0=u32x4{},pw1=u32x4{},pw2=u32x4{},pw3=u32x4{};
  int sl=0,slp=0;
  for(int t=0;t<NT;++t){
    if(t+1<NT) asm volatile("s_waitcnt vmcnt(3) lgkmcnt(0)\n\ts_barrier":::"memory"); else asm volatile("s_waitcnt vmcnt(0) lgkmcnt(0)\n\ts_barrier":::"memory");
    if(t+2<NT){ DMA2(t+2,(sl+2)&3); }
    if(grpB&&t>0) pv16(o,vb0+slp*VS,__builtin_bit_cast(bf16x8,pw0),__builtin_bit_cast(bf16x8,pw1),__builtin_bit_cast(bf16x8,pw2),__builtin_bit_cast(bf16x8,pw3));
    f32x16 p0,p1; qkt(p0,p1,shm+L_K+sl*KS,qr,negm,r32,hi);
    float rm=p0[0];
    #pragma unroll
    for(int r=0;r<16;++r){ rm=__builtin_fmaxf(rm,p0[r]); rm=__builtin_fmaxf(rm,p1[r]); }
    { auto rr=__builtin_amdgcn_permlane32_swap(__float_as_uint(rm),__float_as_uint(rm),false,false); rm=__builtin_fmaxf(__uint_as_float(rr[0]),__uint_as_float(rr[1])); }
    bool resc=false;
    if(t==0){ mhat=rm;
      #pragma unroll
      for(int r=0;r<16;++r){p0[r]-=rm;p1[r]-=rm;}
      #pragma unroll
      for(int r=0;r<16;++r)negm[r]=-mhat; }
    else if(__any(rm>(float)THRL)){ const float dl=__builtin_fmaxf(rm,0.f); mhat+=dl;
      #pragma unroll
      for(int r=0;r<16;++r){p0[r]-=dl;p1[r]-=dl;}
      #pragma unroll
      for(int r=0;r<16;++r)negm[r]=-mhat;
      const float f=__builtin_amdgcn_exp2f(-dl); l_reg*=f; if(hi==0)wsf[r32]=f; resc=true; }
    float sacc=0.f;
    #pragma unroll
    for(int r=0;r<16;++r){ p0[r]=__builtin_amdgcn_exp2f(p0[r]); p1[r]=__builtin_amdgcn_exp2f(p1[r]); sacc+=p0[r]+p1[r]; }
    l_reg+=sacc;
    pw0=(u32x4){cvtpk_s(p0[0],p0[1]),cvtpk_s(p0[2],p0[3]),cvtpk_s(p0[4],p0[5]),cvtpk_s(p0[6],p0[7])};
    pw1=(u32x4){cvtpk_s(p0[8],p0[9]),cvtpk_s(p0[10],p0[11]),cvtpk_s(p0[12],p0[13]),cvtpk_s(p0[14],p0[15])};
    pw2=(u32x4){cvtpk_s(p1[0],p1[1]),cvtpk_s(p1[2],p1[3]),cvtpk_s(p1[4],p1[5]),cvtpk_s(p1[6],p1[7])};
    pw3=(u32x4){cvtpk_s(p1[8],p1[9]),cvtpk_s(p1[10],p1[11]),cvtpk_s(p1[12],p1[13]),cvtpk_s(p1[14],p1[15])};
    if(resc){ asm volatile("s_waitcnt lgkmcnt(0)":::"memory");
      #pragma unroll
      for(int r=0;r<16;++r){ const float f=wsf[crow(r,hi)];
        #pragma unroll
        for(int d_=0;d_<4;++d_) o[d_][r]*=f; } }
    if(!grpB) pv16(o,vb0+sl*VS,__builtin_bit_cast(bf16x8,pw0),__builtin_bit_cast(bf16x8,pw1),__builtin_bit_cast(bf16x8,pw2),__builtin_bit_cast(bf16x8,pw3));
    slp=sl; sl=(sl+1)&3;
  }
  if(grpB) pv16(o,vb0+slp*VS,__builtin_bit_cast(bf16x8,pw0),__builtin_bit_cast(bf16x8,pw1),__builtin_bit_cast(bf16x8,pw2),__builtin_bit_cast(bf16x8,pw3));
  asm volatile("s_waitcnt lgkmcnt(0)\n\ts_barrier":::"memory");
  {auto rr=__builtin_amdgcn_permlane32_swap(__float_as_uint(l_reg),__float_as_uint(l_reg),false,false);l_reg=__uint_as_float(rr[0])+__uint_as_float(rr[1]);}
  if(hi==0)wsf[32+r32]=l_reg; asm volatile("s_waitcnt lgkmcnt(0)":::"memory");
  float rli[16];
  #pragma unroll
  for(int r=0;r<16;++r)rli[r]=__builtin_amdgcn_rcpf(wsf[32+crow(r,hi)]);
  bf16*Ow=Ou+(long)(wid*QBLK)*OP; bf16*stg=(bf16*)(shm+L_OST)+wid*2048;
  #pragma unroll
  for(int e=0;e<2;++e){
    #pragma unroll
    for(int r=0;r<16;++r){const int orow=crow(r,hi);
      #pragma unroll
      for(int d0=0;d0<2;++d0)stg[orow*64+d0*32+r32]=__float2bfloat16(o[2*e+d0][r]*rli[r]);}
    asm volatile("s_waitcnt lgkmcnt(0)":::"memory");
    #pragma unroll
    for(int i=0;i<4;++i){const int row=i*8+(lane>>3),ch=lane&7; const u32x4 v=*(const u32x4*)(stg+row*64+ch*8); ATTN_STORE16(Ow+(long)row*OP+e*64+ch*8,v);}
    asm volatile("s_waitcnt lgkmcnt(0)":::"memory");
  }
  asm volatile("s_waitcnt lgkmcnt(0)\n\ts_barrier":::"memory");
  #undef KROW2
  #undef DMA2
}
constexpr int ATTN_LDS_BYTES=LDS_BYTES;
#undef SBAR
#undef WAIT_BAR
}

#define LAS __attribute__((address_space(3)))
typedef unsigned short bf16;
typedef float f32x4 __attribute__((ext_vector_type(4)));
typedef unsigned u32x4 __attribute__((ext_vector_type(4)));
typedef unsigned u32x2 __attribute__((ext_vector_type(2)));
using pg8::cvt_pk_bf16; using pg8::bf_lo; using pg8::bf_hi; using pg8::fsigmoid; using pg8::fsilu;

constexpr int NWAVES = 8, NTHR = 512;
constexpr int DM = 1024, NX = 16384, NCTX = 1024, MT = NX + NCTX, SEQ = 4096, CTXL = 256, FF = 2816, PXW = 3328, MODW = 9216, INC = 7424;
constexpr int A_OFF = 0, B_OFF = 768, Q_OFF = 1280, K_OFF = 1792, V_OFF = 2304, D_OFF = 2816, G_OFF = 3328;
constexpr float EPS = 1e-6f;
constexpr float C2 = 0.125f * 1.4426950408889634f;
constexpr int LDS_BYTES = 147456;

constexpr size_t MiB = 1u << 20;
constexpr size_t WS_MOD = 0;
constexpr size_t WS_ROPE = 512 * 1024;
constexpr size_t WS_LAM = WS_ROPE + 16384;
constexpr size_t WS_BAR = 640 * 1024;
constexpr size_t WS_W = 1 * MiB;
constexpr size_t LW_UP1 = 0, LW_DN1 = LW_UP1 + (size_t)5632 * 1024, LW_UP2 = LW_DN1 + (size_t)1024 * 2816, LW_DN2 = LW_UP2 + (size_t)5632 * 1024,
                 LW_WIN = LW_DN2 + (size_t)1024 * 2816, LW_AO = LW_WIN + (size_t)INC * 1024, LW_BO = LW_AO + 262144, LW_DO = LW_BO + 262144,
                 LW_CO = LW_DO + 262144, LW_O = LW_CO + 524288, LW_TOTAL = LW_O + 1048576;
static_assert(LW_TOTAL * 2 == 52 * MiB, "weights per layer");
constexpr size_t WS_HN = 105 * MiB;
constexpr size_t WS_PX = 139 * MiB;
constexpr size_t WS_OB = 250 * MiB;
constexpr size_t WS_GS = 284 * MiB;
constexpr size_t WS_ACTD = 316 * MiB;
constexpr size_t WS_CTX = 325 * MiB;
constexpr size_t WS_MGP = 329 * MiB;
constexpr size_t WS_END = 337 * MiB;
constexpr size_t WS_PART = WS_GS;
static_assert(WS_HN + (size_t)MT * 1024 * 2 <= WS_PX && WS_PX + (size_t)MT * PXW * 2 <= WS_OB && WS_OB + (size_t)MT * 1024 * 2 <= WS_GS && WS_ACTD + (size_t)MT * 256 * 2 <= WS_CTX, "ws map");

#define GAS __attribute__((address_space(1)))
#define XB_TMO      128
#define XB_XCNT(j)  (256  + 64 * (j))
#define XB_XSUB(j)  (1280 + 64 * (j))
#define XB_XGEN(j)  (2304 + 64 * (j))
#define XB_TOP      3328
#define XB_TOPGEN   3392
#define XCD_BAR_WORDS 3456
#define XB_SPIN_CAP (1u << 18)

__device__ __forceinline__ unsigned xb_ld(unsigned* p)              { return __hip_atomic_load(p, __ATOMIC_RELAXED, __HIP_MEMORY_SCOPE_AGENT); }
__device__ __forceinline__ unsigned xb_add(unsigned* p, unsigned v) { return __hip_atomic_fetch_add(p, v, __ATOMIC_RELAXED, __HIP_MEMORY_SCOPE_AGENT); }
__device__ __forceinline__ unsigned xb_xcc_id() { return (unsigned)__builtin_amdgcn_s_getreg((3 << 11) | 20) & 0xFu; }
#define XB_SPIN(cond, bar) do { unsigned _sp = 0; while (cond) { \
    if ((++_sp & 255u) == 0u) { if (xb_ld(&(bar)[XB_TMO])) break; if (_sp > XB_SPIN_CAP) { atomicAdd(&(bar)[XB_TMO], 1u); break; } } } } while (0)

struct XcdBarrier {
    unsigned* bar; unsigned x;
    volatile LAS unsigned* st;
};

__device__ __forceinline__ XcdBarrier xcd_barrier_post(unsigned* bar, volatile LAS unsigned* st) {
    XcdBarrier b; b.bar = bar; b.x = xb_xcc_id(); b.st = st;
    if (threadIdx.x == 0) (void)xb_add(&bar[XB_XCNT(b.x)], 1u);
    return b;
}
__device__ __forceinline__ void xcd_barrier_complete(unsigned* bar, unsigned x, unsigned& nloc, unsigned& nx) {
    const unsigned G = gridDim.x * gridDim.y * gridDim.z;
    unsigned sum, cnt, mine, sp = 0u;
    for (;;) {
        sum = 0u; cnt = 0u; mine = 0u;
#pragma unroll
        for (unsigned j = 0; j < 16; ++j) { const unsigned c = xb_ld(&bar[XB_XCNT(j)]); sum += c; cnt += (c > 0u) ? 1u : 0u; mine = (j == x) ? c : mine; }
        if (sum == G) break;
        __builtin_amdgcn_s_sleep(1);
        if ((++sp & 255u) == 0u) { if (xb_ld(&bar[XB_TMO])) break; if (sp > XB_SPIN_CAP) { atomicAdd(&bar[XB_TMO], 1u); break; } }
    }
    nloc = mine > 0u ? mine : 1u; nx = cnt > 0u ? cnt : 1u;
}

__device__ __forceinline__ void xcd_barrier(const XcdBarrier& b) {
    asm volatile("s_waitcnt vmcnt(0)" ::: "memory");
    __syncthreads();
    if (threadIdx.x == 0) {
        unsigned* bar = b.bar;
        __builtin_amdgcn_s_waitcnt(0);
        unsigned nloc = b.st[0], nx = b.st[1];
        if (nloc == 0u) { xcd_barrier_complete(bar, b.x, nloc, nx); b.st[0] = nloc; b.st[1] = nx; }
        const unsigned old = xb_add(&bar[XB_XSUB(b.x)], 1u);
        const unsigned gen = old / nloc;
        if (old + 1u == (gen + 1u) * nloc) {
            __builtin_amdgcn_fence(__ATOMIC_RELEASE, "agent");
            asm volatile("s_waitcnt vmcnt(0)" ::: "memory");
            const unsigned og = xb_add(&bar[XB_TOP], 1u);
            const unsigned tg = og / nx;
            if (og + 1u == (tg + 1u) * nx) xb_add(&bar[XB_TOPGEN], 1u);
            else XB_SPIN(xb_ld(&bar[XB_TOPGEN]) == tg, bar);
            __builtin_amdgcn_fence(__ATOMIC_ACQUIRE, "agent");
            xb_add(&bar[XB_XGEN(b.x)], 1u);
            asm volatile("s_waitcnt vmcnt(0)" ::: "memory");
        } else {
            XB_SPIN(xb_ld(&bar[XB_XGEN(b.x)]) == gen, bar);
            __builtin_amdgcn_fence(__ATOMIC_ACQUIRE, "agent");
            asm volatile("s_waitcnt vmcnt(0)" ::: "memory");
        }
    }
    __syncthreads();
}

struct Params { const float* in[29]; float* out; unsigned char* ws; int ph_lo, ph_hi; };
typedef __attribute__((address_space(4))) const Params* KP;

__device__ __forceinline__ float wave_sum(float v) {
#pragma unroll
    for (int o = 1; o < 64; o <<= 1) v += __shfl_xor(v, o);
    return v;
}

__device__ __forceinline__ void transpose_item(const float* W, int K, int N, bf16* WT, LAS float* scr, int k0, int n0, int drow0, int lane) {
#pragma unroll 8
    for (int i = 0; i < 32; ++i) { const int kk = 2 * i + (lane >> 5); scr[kk * 33 + (lane & 31)] = W[(size_t)(k0 + kk) * N + n0 + (lane & 31)]; }
    asm volatile("s_waitcnt lgkmcnt(0)" ::: "memory");
    const int c = lane & 7;
#pragma unroll
    for (int j = 0; j < 4; ++j) { const int n = (lane >> 3) + 8 * j; const LAS float* s = scr + (8 * c) * 33 + n;
        u32x4 o; o.x = cvt_pk_bf16(s[0 * 33], s[1 * 33]); o.y = cvt_pk_bf16(s[2 * 33], s[3 * 33]); o.z = cvt_pk_bf16(s[4 * 33], s[5 * 33]); o.w = cvt_pk_bf16(s[6 * 33], s[7 * 33]);
        *(u32x4*)(WT + (size_t)(drow0 + n) * K + k0 + 8 * c) = o; }
    asm volatile("s_waitcnt lgkmcnt(0)" ::: "memory");
}
__device__ __forceinline__ bool transpose_mat(int& r, const float* W, int K, int N, bf16* WT, int mode, LAS float* scr, int lane) {
    const int nblk = N / 32, items = (K / 64) * nblk;
    if (r >= items) { r -= items; return false; }
    const int kb = r / nblk, nb = r % nblk, n0 = 32 * nb;
    const int drow0 = (mode == 0) ? n0 : (256 * (n0 >> 7) + (n0 & 127) + (mode == 2 ? 128 : 0));
    transpose_item(W, K, N, WT, scr, 64 * kb, n0, drow0, lane);
    return true;
}

__device__ __forceinline__ void convert_weights(KP pp, unsigned char* lds_g, int l, int widx, int nw, int lane, int wave) {
    LAS float* scr = (LAS float*)((LAS unsigned char*)lds_g + wave * 16384);
    constexpr int ITEMS_L = 13312;
    bf16* WB = (bf16*)(pp->ws + WS_W) + (size_t)l * LW_TOTAL;
    const size_t offf = (size_t)l * 1024 * 2816;
    for (int it = widx; it < ITEMS_L; it += nw) {
        int r = it;
        if (transpose_mat(r, pp->in[7] + offf, 1024, 2816, WB + LW_UP1, 1, scr, lane)) continue;
        if (transpose_mat(r, pp->in[8] + offf, 1024, 2816, WB + LW_UP1, 2, scr, lane)) continue;
        if (transpose_mat(r, pp->in[9] + offf, 2816, 1024, WB + LW_DN1, 0, scr, lane)) continue;
        if (transpose_mat(r, pp->in[10] + offf, 1024, 2816, WB + LW_UP2, 1, scr, lane)) continue;
        if (transpose_mat(r, pp->in[11] + offf, 1024, 2816, WB + LW_UP2, 2, scr, lane)) continue;
        if (transpose_mat(r, pp->in[12] + offf, 2816, 1024, WB + LW_DN2, 0, scr, lane)) continue;
        if (transpose_mat(r, pp->in[13] + (size_t)l * 1024 * INC, 1024, INC, WB + LW_WIN, 0, scr, lane)) continue;
        if (transpose_mat(r, pp->in[15] + (size_t)l * 262144, 256, 1024, WB + LW_AO, 0, scr, lane)) continue;
        if (transpose_mat(r, pp->in[18] + (size_t)l * 262144, 256, 1024, WB + LW_BO, 0, scr, lane)) continue;
        if (transpose_mat(r, pp->in[26] + (size_t)l * 262144, 256, 1024, WB + LW_DO, 0, scr, lane)) continue;
        if (transpose_mat(r, pp->in[21] + (size_t)l * 524288, 512, 1024, WB + LW_CO, 0, scr, lane)) continue;
        transpose_mat(r, pp->in[27] + (size_t)l * 1048576, 1024, 1024, WB + LW_O, 0, scr, lane);
    }
}

__device__ __forceinline__ void prologue(KP pp, unsigned char* lds_g, int tid, int lane, int wave, int vcu, int G) {
    LAS unsigned char* lds = (LAS unsigned char*)lds_g;
    convert_weights(pp, lds_g, 0, vcu * NWAVES + wave, G * NWAVES, lane, wave);
    __syncthreads();
    LAS float* sc = (LAS float*)lds;
    LAS float* part = (LAS float*)(lds + 32768);
    for (int i = tid; i < 5 * 1024; i += NTHR) { const int s = i >> 10, k = i & 1023; const float v = (s < 4) ? pp->in[1][s * 1024 + k] : pp->in[3][k]; sc[i] = fsilu(v); }
    __syncthreads();
    float* MOD = (float*)(pp->ws + WS_MOD);
    for (int it = vcu; it < 2 * 72; it += G) {
        const int l = it / 72, nb = it % 72; const int n = nb * 128 + 2 * lane;
        const float* wa = pp->in[4] + (size_t)l * 1024 * MODW + n;
        typedef float f32x2 __attribute__((ext_vector_type(2)));
        f32x2 a0 = {0.f, 0.f}, a1 = a0, a2 = a0, a3 = a0, a4 = a0;
#pragma unroll 8
        for (int kk = 0; kk < 128; ++kk) { const int k = wave * 128 + kk; const f32x2 w = *(const f32x2*)(wa + (size_t)k * MODW);
            a0 += w * sc[k]; a1 += w * sc[1024 + k]; a2 += w * sc[2048 + k]; a3 += w * sc[3072 + k]; a4 += w * sc[4096 + k]; }
        LAS f32x2* part2 = (LAS f32x2*)part;
        part2[(wave * 5 + 0) * 64 + lane] = a0; part2[(wave * 5 + 1) * 64 + lane] = a1; part2[(wave * 5 + 2) * 64 + lane] = a2; part2[(wave * 5 + 3) * 64 + lane] = a3; part2[(wave * 5 + 4) * 64 + lane] = a4;
        __syncthreads();
        if (tid < 320) { const int s = tid >> 6, cl = tid & 63; f32x2 v = *(const f32x2*)(pp->in[5] + l * MODW + nb * 128 + 2 * cl);
#pragma unroll
            for (int w = 0; w < 8; ++w) v += part2[(w * 5 + s) * 64 + cl];
            *(f32x2*)(MOD + ((size_t)l * 5 + s) * MODW + nb * 128 + 2 * cl) = v; }
        __syncthreads();
    }
    if (blockIdx.x == 0) {
        float* rc = (float*)(pp->ws + WS_ROPE); float* rs = rc + 1024;
        for (int i = tid; i < 1024; i += NTHR) { const int pos = i >> 4, f = i & 15;
            const float inv = exp2f(-(float)f * (13.287712379549449f / 16.0f));
            const float a = (float)pos * inv;
            const float kq = rintf(a * 0.15915494309189535f);
            float rr = fmaf(-kq, 6.2831854820251465f, a); rr = fmaf(-kq, -1.7484556000744883e-7f, rr);
            rc[i] = __cosf(rr); rs[i] = __sinf(rr); }
    }
    if (blockIdx.x == 1 && wave == 0) {
        float* LAM = (float*)(pp->ws + WS_LAM);
        for (int l = 0; l < 2; ++l) { const float* lp = pp->in[19] + l * 256;
            const float sa = wave_sum(lp[lane] * lp[64 + lane]), sb = wave_sum(lp[128 + lane] * lp[192 + lane]);
            int lo = l; float c08 = 0.8f, c06 = 0.6f, c1 = 1.0f; asm volatile("" : "+v"(lo), "+v"(c08), "+v"(c06), "+v"(c1)); const float lam_init = c08 - c06 * expf(-0.3f * (float)lo);
            if (lane == 0) { LAM[l * 2 + 0] = expf(sa) - expf(sb) + lam_init; asm volatile("" ::: "memory"); LAM[l * 2 + 1] = c1 - lam_init; } }
    }
}

__device__ __forceinline__ void norm_phase(KP pp, int l, int which, int lane, int gw, int NGW) {
    const int nrows = (l == 1 && which == 2) ? NX : MT;
    const bool first = (l == 0 && which == 0);
    const float* xs = first ? pp->in[0] : pp->out;
    const float* cs = (l == 0 && which <= 1) ? pp->in[2] : (const float*)(pp->ws + WS_CTX);
    const float* pgate = (const float*)(pp->ws + WS_MOD) + (size_t)((which == 0 ? l - 1 : l) * 5 + 4) * MODW + (which == 1 ? 2 : (which == 2 ? 5 : 8)) * 1024;
    const float pscale = (which == 2) ? 1.0f : 0.5f;
    const float* g = pp->in[6] + (l * 3 + which) * 1024; const float* MOD = (const float*)(pp->ws + WS_MOD) + (size_t)l * 5 * MODW;
    bf16* HN = (bf16*)(pp->ws + WS_HN);
    f32x4 gv[4];
#pragma unroll
    for (int j = 0; j < 4; ++j) gv[j] = *(const f32x4*)(g + 4 * lane + 256 * j);
    for (int blk = gw; blk * 8 < NX; blk += NGW) {
        const int r0 = blk * 8; const int set = r0 >> 12;
        const float* sh = MOD + (size_t)set * MODW + (3 * which) * 1024; const float* scl = sh + 1024;
        f32x4 gs[4], sv[4], cur[4], nxt[4];
#pragma unroll
        for (int j = 0; j < 4; ++j) { sv[j] = *(const f32x4*)(sh + 4 * lane + 256 * j); gs[j] = gv[j] * (*(const f32x4*)(scl + 4 * lane + 256 * j) + 1.0f); }
#pragma unroll
        for (int j = 0; j < 4; ++j) cur[j] = *(const f32x4*)(xs + (size_t)r0 * 1024 + 4 * lane + 256 * j);
#pragma unroll
        for (int i = 0; i < 8; ++i) {
            if (i < 7) {
#pragma unroll
                for (int j = 0; j < 4; ++j) nxt[j] = *(const f32x4*)(xs + (size_t)(r0 + i + 1) * 1024 + 4 * lane + 256 * j); }
            float s2 = 0.f;
#pragma unroll
            for (int j = 0; j < 4; ++j) s2 += (cur[j].x * cur[j].x + cur[j].y * cur[j].y) + (cur[j].z * cur[j].z + cur[j].w * cur[j].w);
            const float rstd = 1.0f / sqrtf(wave_sum(s2) * (1.0f / 1024.0f) + EPS);
#pragma unroll
            for (int j = 0; j < 4; ++j) { const f32x4 y = (cur[j] * rstd) * gs[j] + sv[j];
                u32x2 w; w.x = cvt_pk_bf16(y.x, y.y); w.y = cvt_pk_bf16(y.z, y.w);
                *(u32x2*)(HN + (size_t)(r0 + i) * 1024 + 4 * lane + 256 * j) = w; }
#pragma unroll
            for (int j = 0; j < 4; ++j) cur[j] = nxt[j];
        }
    }
    for (int r = NX + (NGW - 1 - gw); r < nrows; r += NGW) {
        const int set = 4;
        const float* xr = cs + (size_t)(r - NX) * 1024;
        const float* sh = MOD + (size_t)set * MODW + (3 * which) * 1024; const float* scl = sh + 1024;
        f32x4 v[4]; float s2 = 0.f;
#pragma unroll
        for (int j = 0; j < 4; ++j) v[j] = *(const f32x4*)(xr + 4 * lane + 256 * j);
        if (!first) {
            const float* PT = (const float*)(pp->ws + WS_PART) + (size_t)(r - NX) * 1024; float* cw = (float*)(pp->ws + WS_CTX) + (size_t)(r - NX) * 1024;
#pragma unroll
            for (int j = 0; j < 4; ++j) { const int o = 4 * lane + 256 * j;
                f32x4 ps = (*(const f32x4*)(PT + o) + *(const f32x4*)(PT + 1048576 + o)) + (*(const f32x4*)(PT + 2097152 + o) + *(const f32x4*)(PT + 3145728 + o));
                ps = ps + ((*(const f32x4*)(PT + 4194304 + o) + *(const f32x4*)(PT + 5242880 + o)) + (*(const f32x4*)(PT + 6291456 + o) + *(const f32x4*)(PT + 7340032 + o)));
                v[j] = v[j] + *(const f32x4*)(pgate + o) * pscale * ps; *(f32x4*)(cw + o) = v[j]; }
        }
#pragma unroll
        for (int j = 0; j < 4; ++j) s2 += (v[j].x * v[j].x + v[j].y * v[j].y) + (v[j].z * v[j].z + v[j].w * v[j].w);
        const float rstd = 1.0f / sqrtf(wave_sum(s2) * (1.0f / 1024.0f) + EPS);
#pragma unroll
        for (int j = 0; j < 4; ++j) { const f32x4 s = *(const f32x4*)(sh + 4 * lane + 256 * j), cc = *(const f32x4*)(scl + 4 * lane + 256 * j);
            const f32x4 y = (v[j] * rstd) * gv[j] * (cc + 1.0f) + s;
            u32x2 w; w.x = cvt_pk_bf16(y.x, y.y); w.y = cvt_pk_bf16(y.z, y.w);
            *(u32x2*)(HN + (size_t)r * 1024 + 4 * lane + 256 * j) = w; }
    }
}
__device__ __forceinline__ void final_norm(KP pp, int lane, int gw, int NGW) {
    const float* g = pp->in[28];
    f32x4 gg[4];
#pragma unroll
    for (int j = 0; j < 4; ++j) gg[j] = *(const f32x4*)(g + 4 * lane + 256 * j);
    for (int blk = gw; blk * 8 < NX; blk += NGW) { float* x0 = pp->out + (size_t)blk * 8 * 1024;
        f32x4 cur[4], nxt[4];
#pragma unroll
        for (int j = 0; j < 4; ++j) cur[j] = *(const f32x4*)(x0 + 4 * lane + 256 * j);
#pragma unroll
        for (int i = 0; i < 8; ++i) {
            if (i < 7) {
#pragma unroll
                for (int j = 0; j < 4; ++j) nxt[j] = *(const f32x4*)(x0 + (size_t)(i + 1) * 1024 + 4 * lane + 256 * j); }
            float s2 = 0.f;
#pragma unroll
            for (int j = 0; j < 4; ++j) s2 += (cur[j].x * cur[j].x + cur[j].y * cur[j].y) + (cur[j].z * cur[j].z + cur[j].w * cur[j].w);
            const float rstd = 1.0f / sqrtf(wave_sum(s2) * (1.0f / 1024.0f) + EPS);
#pragma unroll
            for (int j = 0; j < 4; ++j) *(f32x4*)(x0 + (size_t)i * 1024 + 4 * lane + 256 * j) = (cur[j] * rstd) * gg[j];
#pragma unroll
            for (int j = 0; j < 4; ++j) cur[j] = nxt[j];
        }
    }
}

__device__ __forceinline__ void unpack8(const u32x4 w, float* f) { f[0] = bf_lo(w.x); f[1] = bf_hi(w.x); f[2] = bf_lo(w.y); f[3] = bf_hi(w.y); f[4] = bf_lo(w.z); f[5] = bf_hi(w.z); f[6] = bf_lo(w.w); f[7] = bf_hi(w.w); }
__device__ __forceinline__ u32x4 pack8(const float* f) { u32x4 w; w.x = cvt_pk_bf16(f[0], f[1]); w.y = cvt_pk_bf16(f[2], f[3]); w.z = cvt_pk_bf16(f[4], f[5]); w.w = cvt_pk_bf16(f[6], f[7]); return w; }
__device__ __forceinline__ void batch_bounds(int r, int& b0, int& b1) { if (r < NX) { b0 = r & ~(SEQ - 1); b1 = b0 + SEQ; } else { b0 = NX + ((r - NX) & ~(CTXL - 1)); b1 = b0 + CTXL; } }

__device__ __forceinline__ void branch_a(KP pp, int l, int nrows, int gtid, int ngt) {
    bf16* PX = (bf16*)(pp->ws + WS_PX); const float* cw = pp->in[14] + l * 768;
    for (int it = gtid; it < nrows * 32; it += ngt) {
        const int r = it >> 5, c0 = (it & 31) * 8; int b0, b1; batch_bounds(r, b0, b1);
        float acc[8];
#pragma unroll
        for (int i = 0; i < 8; ++i) acc[i] = 0.f;
#pragma unroll
        for (int k = 0; k < 3; ++k) { const int rr = r + k - 1;
            if (rr >= b0 && rr < b1) { float cg[8], xi[8]; unpack8(*(const u32x4*)(PX + (size_t)rr * PXW + 256 + c0), cg); unpack8(*(const u32x4*)(PX + (size_t)rr * PXW + 512 + c0), xi);
                const f32x4 w0 = *(const f32x4*)(cw + k * 256 + c0), w1 = *(const f32x4*)(cw + k * 256 + c0 + 4);
                acc[0] += w0.x * cg[0] * xi[0]; acc[1] += w0.y * cg[1] * xi[1]; acc[2] += w0.z * cg[2] * xi[2]; acc[3] += w0.w * cg[3] * xi[3];
                acc[4] += w1.x * cg[4] * xi[4]; acc[5] += w1.y * cg[5] * xi[5]; acc[6] += w1.z * cg[6] * xi[6]; acc[7] += w1.w * cg[7] * xi[7]; } }
        float bg[8]; unpack8(*(const u32x4*)(PX + (size_t)r * PXW + c0), bg);
#pragma unroll
        for (int i = 0; i < 8; ++i) acc[i] *= bg[i];
        *(u32x4*)(PX + (size_t)r * PXW + c0) = pack8(acc);
    }
}

__device__ __forceinline__ void branch_b(KP pp, int l, int nrows, unsigned char* lds_g, int tid, int vcu, int G) {
    bf16* PX = (bf16*)(pp->ws + WS_PX); LAS unsigned short* vt = (LAS unsigned short*)lds_g;
    const int lane = tid & 63, wave = tid >> 6, quad = lane >> 4, l15 = lane & 15;
    const int nunits = (nrows / 128) * 4;
    for (int ut = G - 1 - vcu; ut < nunits; ut += G) {
        const int ch = ut >> 2, g = ut & 3; const int q = tid >> 2, part = tid & 3;
        const bf16* vr = PX + (size_t)(ch * 128 + q) * PXW + 1024;
        float s1 = 0.f, s2 = 0.f;
#pragma unroll
        for (int j = 0; j < 8; ++j) { float f[8]; unpack8(*(const u32x4*)(vr + part * 64 + j * 8), f);
#pragma unroll
            for (int i = 0; i < 8; ++i) { s1 += f[i]; s2 += f[i] * f[i]; } }
        s1 += __shfl_xor(s1, 1); s1 += __shfl_xor(s1, 2); s2 += __shfl_xor(s2, 1); s2 += __shfl_xor(s2, 2);
        const float mean = s1 * (1.0f / 256.0f); const float var = fmaxf(s2 * (1.0f / 256.0f) - mean * mean, 0.f); const float rstd = 1.0f / sqrtf(var + EPS);
#pragma unroll
        for (int j = 0; j < 2; ++j) { float f[8]; unpack8(*(const u32x4*)(vr + g * 64 + part * 16 + j * 8), f);
#pragma unroll
            for (int i = 0; i < 8; i += 2) { const unsigned w = cvt_pk_bf16((f[i] - mean) * rstd, (f[i + 1] - mean) * rstd);
                vt[(part * 16 + j * 8 + i) * 136 + q] = (unsigned short)(w & 0xffffu); vt[(part * 16 + j * 8 + i + 1) * 136 + q] = (unsigned short)(w >> 16); } }
        __syncthreads();
        f32x4 acc[4];
#pragma unroll
        for (int nt = 0; nt < 4; ++nt) acc[nt] = (f32x4){0.f, 0.f, 0.f, 0.f};
        const float* wrow = pp->in[16] + ((size_t)(l * 4 + g) * 128 + 16 * wave + l15) * 128 + 8 * quad;
#pragma unroll
        for (int ks = 0; ks < 4; ++ks) {
            const f32x4 w0 = *(const f32x4*)(wrow + 32 * ks), w1 = *(const f32x4*)(wrow + 32 * ks + 4);
            u32x4 aw; aw.x = cvt_pk_bf16(w0.x, w0.y); aw.y = cvt_pk_bf16(w0.z, w0.w); aw.z = cvt_pk_bf16(w1.x, w1.y); aw.w = cvt_pk_bf16(w1.z, w1.w);
            const pg8::bf16x8 a = __builtin_bit_cast(pg8::bf16x8, aw);
#pragma unroll
            for (int nt = 0; nt < 4; ++nt) { const pg8::bf16x8 b = *(const LAS pg8::bf16x8*)(vt + (16 * nt + l15) * 136 + 32 * ks + 8 * quad);
                acc[nt] = __builtin_amdgcn_mfma_f32_16x16x32_bf16(a, b, acc[nt], 0, 0, 0); }
        }
#pragma unroll
        for (int i = 0; i < 4; ++i) { const int p = 16 * wave + quad * 4 + i; const float bias = pp->in[17][(l * 4 + g) * 128 + p];
            bf16* up = PX + (size_t)(ch * 128 + p) * PXW + 768 + g * 64 + l15;
#pragma unroll
            for (int nt = 0; nt < 4; ++nt) { const float uv = __uint_as_float((unsigned)up[16 * nt] << 16); up[16 * nt] = (bf16)(cvt_pk_bf16(uv * (acc[nt][i] + bias), 0.f) & 0xffffu); } }
        __syncthreads();
    }
}

__device__ __forceinline__ void branch_d(KP pp, int l, int nrows, unsigned char* lds_g, int tid, int lane, int wave, int vcu, int G) {
    const bf16* PX = (const bf16*)(pp->ws + WS_PX); bf16* AD = (bf16*)(pp->ws + WS_ACTD);
    LAS float* hs = (LAS float*)lds_g;
    LAS float* cv = (LAS float*)(lds_g + 65536);
    const float* dw = pp->in[22] + l * 31 * 256; const float* db = pp->in[23] + l * 256; const float* lg = pp->in[24] + l * 256; const float* lb = pp->in[25] + l * 256;
    const int nunits = nrows / 32;
    for (int ut = G - 1 - vcu; ut < nunits; ut += G) {
        const int R0 = ut * 32; int b0, b1; batch_bounds(R0, b0, b1);
        for (int it = tid; it < 62 * 32; it += NTHR) { const int rr = it >> 5, c0 = (it & 31) * 8; const int r = R0 - 15 + rr;
            float h[8];
            if (r >= b0 && r < b1) { float z0[8], z1[8]; unpack8(*(const u32x4*)(PX + (size_t)r * PXW + D_OFF + c0), z0); unpack8(*(const u32x4*)(PX + (size_t)r * PXW + D_OFF + 256 + c0), z1);
#pragma unroll
                for (int i = 0; i < 8; ++i) h[i] = z0[i] * fsigmoid(z1[i]); }
            else {
#pragma unroll
                for (int i = 0; i < 8; ++i) h[i] = 0.f; }
            *(LAS f32x4*)(hs + rr * 256 + c0) = (f32x4){h[0], h[1], h[2], h[3]}; *(LAS f32x4*)(hs + rr * 256 + c0 + 4) = (f32x4){h[4], h[5], h[6], h[7]}; }
        __syncthreads();
        { const int c = tid & 255, half = tid >> 8; const float bias = db[c];
            float o[16];
#pragma unroll
            for (int i = 0; i < 16; ++i) o[i] = bias;
#pragma unroll
            for (int k = 0; k < 31; ++k) { const float w = dw[k * 256 + c];
#pragma unroll
                for (int i = 0; i < 16; ++i) o[i] += w * hs[(half * 16 + i + k) * 256 + c]; }
#pragma unroll
            for (int i = 0; i < 16; ++i) cv[(half * 16 + i) * 256 + c] = o[i]; }
        __syncthreads();
#pragma unroll
        for (int i = 0; i < 4; ++i) { const int rr = wave * 4 + i; const f32x4 v = *(const LAS f32x4*)(cv + rr * 256 + 4 * lane);
            const float mean = wave_sum((v.x + v.y) + (v.z + v.w)) * (1.0f / 256.0f); const f32x4 d = v - mean;
            const float var = wave_sum((d.x * d.x + d.y * d.y) + (d.z * d.z + d.w * d.w)) * (1.0f / 256.0f); const float rstd = 1.0f / sqrtf(var + EPS);
            const f32x4 gg = *(const f32x4*)(lg + 4 * lane), bb = *(const f32x4*)(lb + 4 * lane); const f32x4 y = d * rstd * gg + bb;
            u32x2 w; w.x = cvt_pk_bf16(fsilu(y.x), fsilu(y.y)); w.y = cvt_pk_bf16(fsilu(y.z), fsilu(y.w));
            *(u32x2*)(AD + (size_t)(R0 + rr) * 256 + 4 * lane) = w; }
        __syncthreads();
    }
}

__device__ __forceinline__ void act_c(KP pp, int l, int r0, int h, int tid) {
    const bf16* OB = (const bf16*)(pp->ws + WS_OB); bf16* PX = (bf16*)(pp->ws + WS_PX); const float* LAM = (const float*)(pp->ws + WS_LAM) + l * 2;
    const float lam = LAM[0], oml = LAM[1]; const float* sg = pp->in[20] + l * 128;
    const int sub = tid & 15; f32x4 g0 = *(const f32x4*)(sg + sub * 8), g1 = *(const f32x4*)(sg + sub * 8 + 4);
#pragma unroll
    for (int it = 0; it < 8; ++it) { const int r = r0 + it * 32 + (tid >> 4);
        float a[8], b[8], o[8]; unpack8(*(const u32x4*)(OB + (size_t)r * 1024 + h * 256 + sub * 8), a); unpack8(*(const u32x4*)(OB + (size_t)r * 1024 + h * 256 + 128 + sub * 8), b);
        float s2 = 0.f;
#pragma unroll
        for (int i = 0; i < 8; ++i) { o[i] = a[i] - lam * b[i]; s2 += o[i] * o[i]; }
        s2 += __shfl_xor(s2, 1); s2 += __shfl_xor(s2, 2); s2 += __shfl_xor(s2, 4); s2 += __shfl_xor(s2, 8);
        const float rs = oml / sqrtf(s2 * (1.0f / 128.0f) + EPS);
        o[0] *= rs * g0.x; o[1] *= rs * g0.y; o[2] *= rs * g0.z; o[3] *= rs * g0.w; o[4] *= rs * g1.x; o[5] *= rs * g1.y; o[6] *= rs * g1.z; o[7] *= rs * g1.w;
        *(u32x4*)(PX + (size_t)r * PXW + Q_OFF + h * 128 + sub * 8) = pack8(o); }
}

__device__ __forceinline__ void attn_mix_phase(KP pp, int l, unsigned char* lds_g, int tid, int lane, int wave, int vcu, int G) {
    using abf = attn_body::bf16;
    const abf* PX = (const abf*)(pp->ws + WS_PX); abf* OB = (abf*)(pp->ws + WS_OB);
    const int njobs = 256 + ((l == 0) ? 16 : 0);
    for (int j = vcu; j < njobs; j += G) {
        int b, h, r0, krow0, ntm, krow1, NT;
        if (j < 256) { const int bh = j >> 4, qb = j & 15; b = bh >> 2; h = bh & 3; r0 = b * SEQ + qb * 256; krow0 = b * SEQ; ntm = 64; krow1 = NX + b * CTXL; NT = 68; }
        else { const int w = j - 256; b = w >> 2; h = w & 3; r0 = NX + b * CTXL; krow0 = r0; ntm = 4; krow1 = r0; NT = 4; }
#pragma unroll 1
        for (int me_ = 0; me_ < 2 * MK_REP_ATTN; ++me_) { const int m = me_ & 1;
            attn_body::attn_unit2<8>(PX + (size_t)r0 * PXW + Q_OFF + h * 128 + m * 64, PX + K_OFF + h * 128 + m * 64, PX + V_OFF + h * 128,
                                     OB + (size_t)r0 * 1024 + h * 256 + m * 128, krow0, ntm, krow1, NT, (char*)lds_g); }
        __threadfence(); __syncthreads(); __builtin_amdgcn_fence(__ATOMIC_ACQUIRE, "agent");
        act_c(pp, l, r0, h, tid);
        __syncthreads();
    }
    const int nrows = (l == 0) ? MT : NX;
    branch_a(pp, l, nrows, vcu * NTHR + tid, G * NTHR);
    branch_b(pp, l, nrows, lds_g, tid, vcu, G);
    branch_d(pp, l, nrows, lds_g, tid, lane, wave, vcu, G);
}

__global__ void __launch_bounds__(NTHR, 2) mega_fwd(Params p) {
    extern __shared__ __attribute__((aligned(16))) unsigned char lds[];
    cg::grid_group grid = cg::this_grid();
    KP pk = (KP)__builtin_amdgcn_kernarg_segment_ptr();
    const int ph_lo = pk->ph_lo, ph_hi = pk->ph_hi;
    volatile LAS unsigned* bst = (volatile LAS unsigned*)((LAS unsigned char*)lds + 131072 + 64);
    if (threadIdx.x < 2) bst[threadIdx.x] = 0u;
    __syncthreads();
    XcdBarrier xbar = xcd_barrier_post((unsigned*)(pk->ws + WS_BAR), bst);
    for (int pi = ph_lo; pi < ph_hi; ++pi) {
        const int ph = (MK_REP_PH >= 0 && pi > MK_REP_PH) ? pi - 1 : pi;
        KP pp = pk; asm volatile("" : "+s"(pp));
        const int tid = tid_now(), lane = tid & 63, wave = __builtin_amdgcn_readfirstlane(tid >> 6);
        const int G = gridDim.x; int bx = blockIdx.x; asm volatile("" : "+s"(bx)); const int vcu = (G % 8 == 0) ? (bx % 8) * (G / 8) + bx / 8 : bx;
        const int gw = vcu * NWAVES + wave, NGW = G * NWAVES;
        pg8::LdsPtr ldsp = (pg8::LdsPtr)lds;
        if (ph == 0) prologue(pp, lds, tid, lane, wave, vcu, G);
        else if (ph == 23) final_norm(pp, lane, gw, NGW);
        else {
            const int l = (ph - 1) / 11, s = (ph - 1) % 11;
            bf16* HN = (bf16*)(pp->ws + WS_HN); bf16* PX = (bf16*)(pp->ws + WS_PX); bf16* MG = (bf16*)(pp->ws + WS_OB);
            const bf16* WB = (const bf16*)(pp->ws + WS_W) + (size_t)l * LW_TOTAL;
            if (s == 0 || s == 3 || s == 8) norm_phase(pp, l, s == 0 ? 0 : (s == 3 ? 1 : 2), lane, gw, NGW);
            else if (s == 1 || s == 9) {
                const int Mrows = (l == 1 && s == 9) ? NX : MT;
                pg8::Gemm g{HN, WB + (s == 1 ? LW_UP1 : LW_UP2), 1024, 1024, 1024}; pg8::StaticOrder S; S.init(Mrows, 5632, G, bx);
                pg8::EpiSwiGLU E{PX};
                pg8::gemm_phase<pg8::EpiSwiGLU, pg8::StaticOrder, true, true>(ldsp, g, S, E);
            } else if (s == 2 || s == 7 || s == 10) {
                const bool first = (l == 0 && s == 2); const bool ctxrows = !(l == 1 && s != 2);
                float* CTX = (float*)(pp->ws + WS_CTX); const float* MOD = (const float*)(pp->ws + WS_MOD) + (size_t)l * 5 * MODW;
                const bf16* A = (s == 7) ? MG : PX; const int lda = (s == 7) ? 1024 : FF; const int K = lda;
                const bf16* W = WB + (s == 2 ? LW_DN1 : (s == 7 ? LW_O : LW_DN2));
                { pg8::Gemm g{A, W, lda, K, K}; pg8::StaticOrder S; S.init(NX, 1024, G, bx);
                  pg8::EpiRes E{first ? pp->in[0] : pp->out, CTX, pp->out, CTX, MOD + (s == 2 ? 2 : (s == 7 ? 5 : 8)) * 1024, (s == 7) ? 1.0f : 0.5f};
                  pg8::gemm_phase<pg8::EpiRes, pg8::StaticOrder, true, true>(ldsp, g, S, E); }
                if (ctxrows && (bx & 1) == 1) {
                    KP pq = pk; asm volatile("" : "+s"(pq));
                    const int j = bx >> 1, ut = j >> 3, sp = j & 7;
                    pg8::OneUnit S1{pg8::Unit{64 + (ut >> 2), ut & 3}};
                    const bf16* WB2 = (const bf16*)(pq->ws + WS_W) + (size_t)l * LW_TOTAL; float* PT = (float*)(pq->ws + WS_PART) + (size_t)sp * 1048576;
                    const bf16* A2; const bf16* W2; int ld2, kc;
                    if (s == 7) { const int kh = (sp & 1) * 512;
                        A2 = (const bf16*)(pq->ws + WS_MGP) + (size_t)(sp >> 1) * 1048576 - (size_t)NX * 1024 + kh; W2 = WB2 + LW_O + kh; ld2 = 1024; kc = 512;
                    } else { const int k0 = (sp < 6) ? sp * 384 : 2304 + (sp - 6) * 256;
                        A2 = (const bf16*)(pq->ws + WS_PX) + k0; W2 = WB2 + (s == 2 ? LW_DN1 : LW_DN2) + k0; ld2 = FF; kc = (sp < 6) ? 384 : 256; }
                    pg8::Gemm g{A2, W2, ld2, ld2, kc}; pg8::EpiPart E{PT};
                    pg8::gemm_phase<pg8::EpiPart, pg8::OneUnit, true, true>(ldsp, g, S1, E);
                }
            } else if (s == 4) {
                pg8::Gemm g{HN, WB + LW_WIN, 1024, 1024, 1024}; pg8::StaticOrder S; S.init(MT, PXW, G, bx);
                pg8::EpiWin E{PX, (const float*)(pp->ws + WS_ROPE), (const float*)(pp->ws + WS_ROPE) + 1024, C2};
                pg8::gemm_phase<pg8::EpiWin, pg8::StaticOrder, true, true>(ldsp, g, S, E);
            } else if (s == 5) attn_mix_phase(pp, l, lds, tid, lane, wave, vcu, G);
            else if (s == 6) {
                const int nctx = (l == 0 && (bx & 3) == 1) ? 1 : 0;
                pg8::StaticOrder S; S.init(NX, 1024, G, bx); pg8::Unit u;
                for (int i = 0; i < 1 + nctx; ++i) {
                    int br_lo = 0, br_hi = 4;
                    if (i == 0) { if (!S.next(0, u)) continue; }
                    else { const int j = bx >> 2, ut = j >> 2; u.pm = 64 + (ut >> 2); u.pn = ut & 3; br_lo = j & 3; br_hi = br_lo + 1; }
#pragma unroll 1
                    for (int br = br_lo; br < br_hi; ++br) {
                        if (!((MK_BRMASK >> br) & 1)) continue;
                        KP pq = pk; asm volatile("" : "+s"(pq));
                        bf16* GSw = (bf16*)(pq->ws + WS_GS) + (size_t)bx * 65536; const bf16* HN2 = (const bf16*)(pq->ws + WS_HN);
                        const bf16* WB2 = (const bf16*)(pq->ws + WS_W) + (size_t)l * LW_TOTAL;
                        pg8::OneUnit S1{u};
                        { pg8::Gemm g{HN2, WB2 + LW_WIN + (size_t)(G_OFF + br * 1024) * 1024, 1024, 1024, 1024}; pg8::EpiGate E{GSw};
                          pg8::gemm_phase<pg8::EpiGate, pg8::OneUnit, true, true>(ldsp, g, S1, E); }
                        const bf16* PX2 = (const bf16*)(pq->ws + WS_PX);
                        const bf16* A = (br == 0) ? PX2 + A_OFF : (br == 1) ? PX2 + B_OFF : (br == 2) ? PX2 + Q_OFF : (const bf16*)(pq->ws + WS_ACTD);
                        const int lda = (br == 3) ? 256 : PXW; const int K = (br == 2) ? 512 : 256;
                        const bf16* W = WB2 + ((br == 0) ? LW_AO : (br == 1) ? LW_BO : (br == 2) ? LW_CO : LW_DO);
                        bf16* MGd = (i == 0) ? (bf16*)(pq->ws + WS_OB) : (bf16*)(pq->ws + WS_MGP) + (size_t)br * 1048576 - (size_t)NX * 1024;
                        { pg8::Gemm g{A, W, lda, K, K}; pg8::EpiBranch E{GSw, MGd, (i == 0) ? ((MK_BRMASK & ((1 << br) - 1)) == 0) : 1};
                          pg8::gemm_phase<pg8::EpiBranch, pg8::OneUnit, true, true>(ldsp, g, S1, E); }
                    }
                }
                if (l == 0 && (bx & 3) != 1) {
                    KP pq = pk; asm volatile("" : "+s"(pq));
                    convert_weights(pq, lds, 1, (bx - ((bx + 2) >> 2)) * NWAVES + wave, (G - G / 4) * NWAVES, lane, wave);
                }
            }
        }
        if (pi + 1 < ph_hi) {
            if (ph_hi > 4096) grid.sync();
            xcd_barrier(xbar);
        }
    }
}


extern "C" void kernel_launch(void* const* d_in, const int* in_sizes, int n_in, void* d_out, int out_size, void* d_ws, size_t ws_size, hipStream_t stream) {
    static int grid = 0;
    if (grid == 0) {
        if (n_in != 29 || out_size != NX * 1024 || ws_size < WS_END) { fprintf(stderr, "kernel_launch: unexpected shapes / workspace (n_in %d out %d ws %zu)\n", n_in, out_size, ws_size); grid = -1; return; }
        int dev = 0, cus = 0, per_cu = 0;
        if (hipGetDevice(&dev) != hipSuccess || hipDeviceGetAttribute(&cus, hipDeviceAttributeMultiprocessorCount, dev) != hipSuccess) { grid = -1; return; }
        if (hipFuncSetAttribute((const void*)mega_fwd, hipFuncAttributeMaxDynamicSharedMemorySize, LDS_BYTES) != hipSuccess) { fprintf(stderr, "kernel_launch: hipFuncSetAttribute failed\n"); grid = -1; return; }
        if (hipOccupancyMaxActiveBlocksPerMultiprocessor(&per_cu, (const void*)mega_fwd, NTHR, LDS_BYTES) != hipSuccess || per_cu < 1) { fprintf(stderr, "kernel_launch: occupancy query says %d\n", per_cu); per_cu = 1; }
        (void)hipGetLastError();
        grid = cus;
    }
    if (grid < 0) return;
    if (hipMemsetAsync((char*)d_ws + WS_BAR, 0, 16384, stream) != hipSuccess) { fprintf(stderr, "kernel_launch: memset failed\n"); return; }
    Params p{};
    for (int i = 0; i < 29; ++i) p.in[i] = (const float*)d_in[i];
    p.out = (float*)d_out; p.ws = (unsigned char*)d_ws;
#if MK_PER_PHASE
    for (int ph = 0; ph < 24; ++ph) { if (ph >= MK_NPH && ph != 23) continue; p.ph_lo = ph; p.ph_hi = ph + 1; hipLaunchKernelGGL(mega_fwd, dim3(grid), dim3(NTHR), LDS_BYTES, stream, p); }
#else
    p.ph_lo = 0; p.ph_hi = 24 + ((MK_REP_PH >= 0) ? 1 : 0);
    void* args[] = {&p};
    hipError_t e = hipLaunchCooperativeKernel((const void*)mega_fwd, dim3(grid), dim3(NTHR), args, LDS_BYTES, stream);
    if (e != hipSuccess) fprintf(stderr, "cooperative launch failed: %s (grid %d)\n", hipGetErrorString(e), grid);
#endif
}
```
